# Optimizing an MI355X kernel written in HIP

```python
import math
import jax, jax.numpy as jnp
from jax import lax
import numpy as np

D_MODEL = 1024
BATCH = 4
SEQ = 8192
DEPTH = 1

CHUNK = 64
Q_BLOCK = 128

GLA_HEADS = 4
GLA_DK = 128
GLA_DV = 256
GLA_LOWRANK = 16
GLA_GATE_TEMP = 16.0

MLA_HEADS = 8
MLA_Q_LORA = 384
MLA_KV_LORA = 256
MLA_NOPE = 128
MLA_ROPE = 64
MLA_V = 128
ROPE_THETA = 10000.0

D_FF = ((8 * D_MODEL // 3 + 255) // 256) * 256

NORM_EPS = 1e-6

IN_SPLITS = (
    GLA_HEADS * GLA_DK,
    GLA_HEADS * GLA_DK,
    GLA_HEADS * GLA_DV,
    GLA_HEADS * GLA_DV,
    GLA_LOWRANK,
    MLA_Q_LORA,
    MLA_KV_LORA,
    MLA_ROPE,
)
D_IN = sum(IN_SPLITS)
GLA_WIDTH = GLA_HEADS * GLA_DV
MLA_WIDTH = MLA_HEADS * MLA_V

kernel_name = "hybrid_gla_mla_gated_sandwich_block"


def rms_norm(x, g):
    xf = x.astype(jnp.float32)
    y = xf * lax.rsqrt(jnp.mean(xf * xf, axis=-1, keepdims=True) + NORM_EPS)
    return (y * g.astype(jnp.float32)).astype(x.dtype)


def rope_tables(positions):
    inv_freq = 1.0 / (ROPE_THETA ** (jnp.arange(0, MLA_ROPE, 2, dtype=jnp.float32) / MLA_ROPE))
    ang = positions.astype(jnp.float32)[..., None] * inv_freq
    return jnp.cos(ang), jnp.sin(ang)


def apply_rope(x, cos, sin):
    half = x.shape[-1] // 2
    x1 = x[..., :half].astype(jnp.float32)
    x2 = x[..., half:].astype(jnp.float32)
    out = jnp.concatenate([x1 * cos - x2 * sin, x2 * cos + x1 * sin], axis=-1)
    return out.astype(x.dtype)


def gla_branch(h_q, h_k, h_v, h_g, h_a, w_a2, b_a2, gla_norm):
    B, S, _ = h_q.shape
    n_chunks = S // CHUNK
    f32 = jnp.float32
    q = h_q.reshape(B, S, GLA_HEADS, GLA_DK).astype(f32) * (GLA_DK ** -0.5)
    k = h_k.reshape(B, S, GLA_HEADS, GLA_DK).astype(f32)
    v = h_v.reshape(B, S, GLA_HEADS, GLA_DV).astype(f32)
    log_a = jax.nn.log_sigmoid((h_a @ w_a2 + b_a2).astype(f32)) / GLA_GATE_TEMP
    log_a = log_a.reshape(B, S, GLA_HEADS, GLA_DK)

    def to_chunks(t):
        return t.reshape(B, n_chunks, CHUNK, GLA_HEADS, t.shape[-1]).transpose(1, 0, 3, 2, 4)

    q, k, v, log_a = to_chunks(q), to_chunks(k), to_chunks(v), to_chunks(log_a)
    b = jnp.cumsum(log_a, axis=3)
    b_end = b[:, :, :, -1:, :]
    k_dec = k * jnp.exp(b_end - b)
    chunk_decay = jnp.exp(b_end[:, :, :, 0, :])

    def step(state, inp):
        qc, kc, vc, dc = inp
        state = dc[..., None] * state + jnp.einsum('bhck,bhcv->bhkv', kc, vc)
        out = jnp.einsum('bhck,bhkv->bhcv', qc, state)
        return state, out

    state0 = jnp.zeros((B, GLA_HEADS, GLA_DK, GLA_DV), f32)
    _, o = lax.scan(step, state0, (q, k_dec, v, chunk_decay))
    o = o.transpose(1, 0, 3, 2, 4).reshape(B, S, GLA_HEADS, GLA_DV)
    o = rms_norm(o, gla_norm)
    g = h_g.reshape(B, S, GLA_HEADS, GLA_DV).astype(f32)
    o = o * jax.nn.silu(g)
    return o.reshape(B, S, GLA_WIDTH).astype(h_q.dtype)


def mla_branch(c_q, c_kv, k_pe, cos, sin, q_norm, w_uq, kv_norm, w_ukv):
    B, S, _ = c_q.shape
    q = (rms_norm(c_q, q_norm) @ w_uq).reshape(B, S, MLA_HEADS, MLA_NOPE + MLA_ROPE)
    q_nope = q[..., :MLA_NOPE]
    q_pe = apply_rope(q[..., MLA_NOPE:], cos[:, :, None, :], sin[:, :, None, :])
    kv = (rms_norm(c_kv, kv_norm) @ w_ukv).reshape(B, S, MLA_HEADS, MLA_NOPE + MLA_V)
    k_nope = kv[..., :MLA_NOPE]
    v = kv[..., MLA_NOPE:]
    k_pe = apply_rope(k_pe, cos, sin)
    scale = (MLA_NOPE + MLA_ROPE) ** -0.5
    n_blocks = S // Q_BLOCK

    def blocks(t):
        return t.reshape(B, n_blocks, Q_BLOCK, MLA_HEADS, t.shape[-1]).transpose(1, 0, 2, 3, 4)

    key_chunk = jnp.arange(S) // CHUNK

    def attend(args):
        qn_b, qp_b, blk = args
        s = (jnp.einsum('bqhd,bkhd->bhqk', qn_b, k_nope)
             + jnp.einsum('bqhr,bkr->bhqk', qp_b, k_pe)).astype(jnp.float32) * scale
        q_chunk = (blk * Q_BLOCK + jnp.arange(Q_BLOCK)) // CHUNK
        mask = key_chunk[None, :] <= q_chunk[:, None]
        s = jnp.where(mask[None, None], s, -jnp.inf)
        p = jax.nn.softmax(s, axis=-1).astype(v.dtype)
        return jnp.einsum('bhqk,bkhd->bqhd', p, v)

    o = lax.map(attend, (blocks(q_nope), blocks(q_pe), jnp.arange(n_blocks)))
    return o.transpose(1, 0, 2, 3, 4).reshape(B, S, MLA_WIDTH)


def setup_inputs(seed: int = 0) -> dict:
    key = jax.random.key(seed)
    ks = jax.random.split(key, 24)
    f32 = jnp.float32

    def w(k, shape, fan_in):
        return jax.random.normal(k, shape, f32) * (fan_in ** -0.5)

    def gain(k, dim):
        return 1.0 + 0.02 * jax.random.normal(k, (DEPTH, dim), f32)

    x = jax.random.normal(ks[0], (BATCH, SEQ, D_MODEL), f32)
    offsets = jax.random.randint(ks[1], (BATCH, 1), 0, 4096, dtype=jnp.int32)
    positions = offsets + jnp.arange(SEQ, dtype=jnp.int32)[None, :]
    return {
        "x": x,
        "positions": positions,
        "pre_mix_norm": gain(ks[2], D_MODEL),
        "w_in": w(ks[3], (DEPTH, D_MODEL, D_IN), D_MODEL),
        "w_a2": w(ks[4], (DEPTH, GLA_LOWRANK, GLA_HEADS * GLA_DK), GLA_LOWRANK),
        "b_a2": 0.1 * jax.random.normal(ks[5], (DEPTH, GLA_HEADS * GLA_DK), f32),
        "gla_norm": gain(ks[6], GLA_DV),
        "w_o_gla": w(ks[7], (DEPTH, GLA_WIDTH, D_MODEL), GLA_WIDTH),
        "q_norm": gain(ks[8], MLA_Q_LORA),
        "w_uq": w(ks[9], (DEPTH, MLA_Q_LORA, MLA_HEADS * (MLA_NOPE + MLA_ROPE)), MLA_Q_LORA),
        "kv_norm": gain(ks[10], MLA_KV_LORA),
        "w_ukv": w(ks[11], (DEPTH, MLA_KV_LORA, MLA_HEADS * (MLA_NOPE + MLA_V)), MLA_KV_LORA),
        "w_o_mla": w(ks[12], (DEPTH, MLA_WIDTH, D_MODEL), MLA_WIDTH),
        "w_gate": w(ks[13], (DEPTH, D_MODEL, 2 * D_MODEL), D_MODEL),
        "b_gate": 0.02 * jax.random.normal(ks[14], (DEPTH, 2 * D_MODEL), f32),
        "w_out": w(ks[15], (DEPTH, D_MODEL, D_MODEL), D_MODEL),
        "post_mix_norm": gain(ks[16], D_MODEL),
        "pre_ffn_norm": gain(ks[17], D_MODEL),
        "w_ffn_gate": w(ks[18], (DEPTH, D_MODEL, D_FF), D_MODEL),
        "w_ffn_up": w(ks[19], (DEPTH, D_MODEL, D_FF), D_MODEL),
        "w_ffn_down": w(ks[20], (DEPTH, D_FF, D_MODEL), D_FF),
        "post_ffn_norm": gain(ks[21], D_MODEL),
    }


def reference(x, positions, pre_mix_norm, w_in, w_a2, b_a2, gla_norm, w_o_gla,
              q_norm, w_uq, kv_norm, w_ukv, w_o_mla, w_gate, b_gate, w_out,
              post_mix_norm, pre_ffn_norm, w_ffn_gate, w_ffn_up, w_ffn_down,
              post_ffn_norm):
    cos, sin = rope_tables(positions)
    split_points = list(np.cumsum(IN_SPLITS)[:-1])
    for l in range(DEPTH):
        h = rms_norm(x, pre_mix_norm[l])
        proj = h @ w_in[l]
        h_q, h_k, h_v, h_g, h_a, c_q, c_kv, k_pe = jnp.split(proj, split_points, axis=-1)
        y_a = gla_branch(h_q, h_k, h_v, h_g, h_a, w_a2[l], b_a2[l], gla_norm[l]) @ w_o_gla[l]
        y_b = mla_branch(c_q, c_kv, k_pe, cos, sin, q_norm[l], w_uq[l], kv_norm[l], w_ukv[l]) @ w_o_mla[l]
        gates = jax.nn.sigmoid(h @ w_gate[l] + b_gate[l])
        g_a, g_b = jnp.split(gates, 2, axis=-1)
        mixed = (g_a * y_a + g_b * y_b) @ w_out[l]
        x = x + rms_norm(mixed, post_mix_norm[l])
        h = rms_norm(x, pre_ffn_norm[l])
        f = (jax.nn.silu(h @ w_ffn_gate[l]) * (h @ w_ffn_up[l])) @ w_ffn_down[l]
        x = x + rms_norm(f, post_ffn_norm[l])
    return x
```

```cpp
#include <hip/hip_runtime.h>
#include <hip/hip_bf16.h>
#include <hip/hip_cooperative_groups.h>
#include <cstdio>
#include <cstdint>
namespace cg = cooperative_groups;
namespace pg8 {
#define PG8_LAS __attribute__((address_space(3)))
typedef unsigned short bf16_t;
typedef short bf16x8 __attribute__((ext_vector_type(8)));
typedef float f32x4 __attribute__((ext_vector_type(4)));
typedef unsigned u32x4 __attribute__((ext_vector_type(4)));
constexpr int BM = 256, BK = 64, HALF = 128, HTB = HALF * BK * 2  , STAGE_BYTES = 8 * HTB, NXCD = 8, WGM = 8;

__host__ __device__ __forceinline__ int lds_byte(int r, int c) { const int st = (r >> 4) * 2 + (c >> 5), rr = r & 15, cc = c & 31, ob = rr * 64 + cc * 2; return st * 1024 + (ob ^ (((ob >> 9) & 1) << 5)); }
__host__ __device__ __forceinline__ void stage_rc(int b, int& R, int& C) { const int st = b / 1024, sb = b % 1024, swz = sb ^ (((sb >> 9) & 1) << 5); R = (st >> 1) * 16 + swz / 64; C = (st & 1) * 32 + (swz % 64) / 2; }
__host__ __device__ __forceinline__ int perm32(int rho) { const int n = rho >> 4, i = rho & 15; return 8 * (i >> 2) + 4 * n + (i & 3); }

struct Unit { int pm, pn; };
struct Gemm { const bf16_t* A; const bf16_t* Bt; int M, N, K, lda; };

struct StaticOrder {
    int nM, nN, nwg, G, c;
    __host__ __device__ void init(int M, int N, int G_, int c_) { nM = M / BM; nN = N / BM; nwg = nM * nN; G = G_; c = c_; }
    __host__ __device__ bool next(int i, Unit& u) const {
        const long L = (long)i * G + c; if (L >= nwg) return false;
        int wgid = (int)L; { const int q = nwg / NXCD, r = nwg % NXCD, xcd = wgid % NXCD, off = wgid / NXCD; wgid = (xcd < r ? xcd * (q + 1) : r * (q + 1) + (xcd - r) * q) + off; }
        const int nig = WGM * nN, gid = wgid / nig, fm = gid * WGM, gsz = (nM - fm) < WGM ? (nM - fm) : WGM;
        u.pm = fm + ((wgid % nig) % gsz); u.pn = (wgid % nig) / gsz; return true;
    }
    __device__ __forceinline__ void a_ready(const Unit&) const {}
    __device__ __forceinline__ void done(const Unit&) const {}
};

__device__ __forceinline__ unsigned cvt_pk_bf16(float lo, float hi) { unsigned r; asm volatile("v_cvt_pk_bf16_f32 %0, %1, %2" : "=v"(r) : "v"(lo), "v"(hi)); return r; }
typedef float f32x2 __attribute__((ext_vector_type(2)));
template <class Epi, class Sched, bool ALIGN_EPI = false, bool SP2 = false>
__device__ __forceinline__ void gemm_phase(PG8_LAS unsigned char* lds, const Gemm g, const Sched& S, const Epi& E) {
    int tid_ = threadIdx.x; asm volatile("" : "+v"(tid_));
    const int tid = tid_, wid = __builtin_amdgcn_readfirstlane(tid >> 6), lane = tid & 63, wr = wid >> 2, wc = wid & 3, fr = lane & 15, fq = lane >> 4;
    const int K = g.K, nt = K / BK;
    unsigned voffA[2], voffB[2];
#pragma unroll
    for (int i = 0; i < 2; ++i) { int R, C; stage_rc(tid * 16 + i * 8192, R, C); const int Rb = Epi::PERM ? ((R & ~31) + perm32(R & 31)) : R;
        voffA[i] = (unsigned)(R * g.lda + C) * 2u; voffB[i] = (unsigned)(Rb * K + C) * 2u; }
    const size_t kstep = (size_t)(BK * 2);
    const size_t hstepA = (size_t)HALF * g.lda * 2, hstepB = (size_t)HALF * K * 2;
    const size_t tstepA = 2 * hstepA, tstepB = 2 * hstepB;
    const unsigned ldsw = (unsigned)wid * 1024u;
    const int aoff = lds_byte(wr * 64 + fr, fq * 8), boff = lds_byte(wc * 32 + fr, fq * 8);
#define PG8_SA(b, h) (((b) * 2 + (h)) * HTB)
#define PG8_SB(b, h) ((4 + (b) * 2 + (h)) * HTB)
#define PG8_STAGE(bufoff, gbase, voff) do { _Pragma("unroll") for (int _i = 0; _i < 2; ++_i) \
        __builtin_amdgcn_global_load_lds((const unsigned*)((const char*)(gbase) + (voff)[_i]), (PG8_LAS unsigned*)(lds + (bufoff) + ldsw + _i * 8192), 16, 0, 0); } while (0)
#define PG8_LDA(dst, b, h) do { _Pragma("unroll") for (int m = 0; m < 4; ++m) _Pragma("unroll") for (int k = 0; k < 2; ++k) dst[m][k] = *(const PG8_LAS bf16x8*)(lds + PG8_SA(b, h) + aoff + m * 2048 + k * 1024); } while (0)
#define PG8_LDB(dst, b, h) do { _Pragma("unroll") for (int n = 0; n < 2; ++n) _Pragma("unroll") for (int k = 0; k < 2; ++k) dst[n][k] = *(const PG8_LAS bf16x8*)(lds + PG8_SB(b, h) + boff + n * 2048 + k * 1024); } while (0)
#define PG8_MMA(ai, bj, At, Bt) do { __builtin_amdgcn_s_setprio(1); _Pragma("unroll") for (int m = 0; m < 4; ++m) _Pragma("unroll") for (int n = 0; n < 2; ++n) _Pragma("unroll") for (int k = 0; k < 2; ++k) \
        acc[ai][bj][m][n] = __builtin_amdgcn_mfma_f32_16x16x32_bf16(Bt[n][k], At[m][k], acc[ai][bj][m][n], 0, 0, 0); __builtin_amdgcn_s_setprio(0); } while (0)
#define PG8_WAIT_V(n) asm volatile("s_waitcnt vmcnt(" #n ")" ::: "memory")
#define PG8_WAIT_L(n) asm volatile("s_waitcnt lgkmcnt(" #n ")" ::: "memory")
#define PG8_BAR __builtin_amdgcn_s_barrier()
#define PG8_SCHED __builtin_amdgcn_sched_barrier(0)
    Unit cur, nxt; int ui = 0;
    if (!S.next(0, cur)) return;
    f32x4 acc[2][2][4][2];
#pragma unroll
    for (int a = 0; a < 2; ++a)
#pragma unroll
        for (int b = 0; b < 2; ++b)
#pragma unroll
            for (int m = 0; m < 4; ++m)
#pragma unroll
                for (int n = 0; n < 2; ++n) acc[a][b][m][n] = (f32x4){0.f, 0.f, 0.f, 0.f};
    bf16x8 At[4][2], B0[2][2], B1[2][2];
    const char* cA = (const char*)g.A + (size_t)cur.pm * tstepA; const char* cB = (const char*)g.Bt + (size_t)cur.pn * tstepB;
    S.a_ready(cur);
    if constexpr (SP2) {
        PG8_STAGE(PG8_SB(0, 0), cB, voffB); PG8_STAGE(PG8_SB(0, 1), cB + hstepB, voffB); PG8_STAGE(PG8_SA(0, 0), cA, voffA); PG8_STAGE(PG8_SA(0, 1), cA + hstepA, voffA);
        if (wr == 1) PG8_BAR;
        PG8_WAIT_V(2); PG8_BAR;
        PG8_STAGE(PG8_SB(1, 0), cB + kstep, voffB); PG8_STAGE(PG8_SA(1, 0), cA + kstep, voffA); PG8_STAGE(PG8_SB(1, 1), cB + hstepB + kstep, voffB);
        PG8_WAIT_V(6); PG8_BAR;
    } else {
        PG8_STAGE(PG8_SB(0, 0), cB, voffB); PG8_STAGE(PG8_SA(0, 0), cA, voffA); PG8_STAGE(PG8_SB(0, 1), cB + hstepB, voffB); PG8_STAGE(PG8_SA(0, 1), cA + hstepA, voffA);
        if (wr == 1) PG8_BAR;
        PG8_WAIT_V(4); PG8_BAR;
        PG8_STAGE(PG8_SB(1, 0), cB + kstep, voffB); PG8_STAGE(PG8_SA(1, 0), cA + kstep, voffA); PG8_STAGE(PG8_SB(1, 1), cB + hstepB + kstep, voffB);
        PG8_WAIT_V(6); PG8_BAR;
    }
    for (;;) {
        const bool has_next = S.next(ui + 1, nxt);
        const char* nA = has_next ? (const char*)g.A + (size_t)nxt.pm * tstepA : cA; const char* nB = has_next ? (const char*)g.Bt + (size_t)nxt.pn * tstepB : cB;
        for (int t = 0; t < nt; t += 2) {
            const bool last = (t == nt - 2);
            const char* a1 = cA + (size_t)(t + 1) * kstep;
            const char* a2 = last ? nA : cA + (size_t)(t + 2) * kstep; const char* b2 = last ? nB : cB + (size_t)(t + 2) * kstep;
            const char* a3 = a2 + kstep; const char* b3 = b2 + kstep;
            if (last && has_next) S.a_ready(nxt);
            if constexpr (SP2) {
            PG8_LDB(B0, 0, 0); PG8_LDB(B1, 0, 1); PG8_SCHED; PG8_LDA(At, 0, 0); PG8_STAGE(PG8_SA(1, 1), a1 + hstepA, voffA);
            PG8_WAIT_V(8); PG8_WAIT_L(0); PG8_BAR; PG8_MMA(0, 0, At, B0); PG8_MMA(0, 1, At, B1); PG8_BAR; PG8_SCHED;
            PG8_LDA(At, 0, 1); PG8_STAGE(PG8_SB(0, 0), b2, voffB); PG8_STAGE(PG8_SB(0, 1), b2 + hstepB, voffB); PG8_STAGE(PG8_SA(0, 0), a2, voffA);
            PG8_WAIT_V(8); PG8_WAIT_L(0); PG8_BAR; PG8_MMA(1, 0, At, B0); PG8_MMA(1, 1, At, B1); PG8_BAR; PG8_SCHED;
            PG8_LDB(B0, 1, 0); PG8_LDB(B1, 1, 1); PG8_SCHED; PG8_LDA(At, 1, 0); PG8_STAGE(PG8_SA(0, 1), a2 + hstepA, voffA);
            PG8_WAIT_V(8); PG8_WAIT_L(0); PG8_BAR; PG8_MMA(0, 0, At, B0); PG8_MMA(0, 1, At, B1); PG8_BAR; PG8_SCHED;
            PG8_LDA(At, 1, 1); PG8_STAGE(PG8_SB(1, 0), b3, voffB); PG8_STAGE(PG8_SB(1, 1), b3 + hstepB, voffB); PG8_STAGE(PG8_SA(1, 0), a3, voffA);
            PG8_WAIT_V(8); PG8_WAIT_L(0); PG8_BAR; PG8_MMA(1, 0, At, B0); PG8_MMA(1, 1, At, B1); PG8_BAR; PG8_SCHED;
            } else {
            PG8_LDB(B0, 0, 0); PG8_SCHED; PG8_LDA(At, 0, 0); PG8_STAGE(PG8_SA(1, 1), a1 + hstepA, voffA);
            PG8_WAIT_L(8); PG8_BAR; PG8_WAIT_L(0); PG8_MMA(0, 0, At, B0); PG8_BAR; PG8_SCHED;
            PG8_LDB(B1, 0, 1); PG8_STAGE(PG8_SB(0, 0), b2, voffB);
            PG8_BAR; PG8_WAIT_L(0); PG8_MMA(0, 1, At, B1); PG8_BAR;
            PG8_LDA(At, 0, 1); PG8_STAGE(PG8_SA(0, 0), a2, voffA);
            PG8_BAR; PG8_WAIT_L(0); PG8_MMA(1, 0, At, B0); PG8_BAR; PG8_SCHED;
            PG8_STAGE(PG8_SB(0, 1), b2 + hstepB, voffB);
            PG8_WAIT_V(6); PG8_BAR; PG8_MMA(1, 1, At, B1); PG8_BAR;
            PG8_LDB(B0, 1, 0); PG8_SCHED; PG8_LDA(At, 1, 0); PG8_STAGE(PG8_SA(0, 1), a2 + hstepA, voffA);
            PG8_WAIT_L(8); PG8_BAR; PG8_WAIT_L(0); PG8_MMA(0, 0, At, B0); PG8_BAR; PG8_SCHED;
            PG8_LDB(B1, 1, 1); PG8_STAGE(PG8_SB(1, 0), b3, voffB);
            PG8_BAR; PG8_WAIT_L(0); PG8_MMA(0, 1, At, B1); PG8_BAR;
            PG8_LDA(At, 1, 1); PG8_STAGE(PG8_SA(1, 0), a3, voffA);
            PG8_BAR; PG8_WAIT_L(0); PG8_MMA(1, 0, At, B0); PG8_BAR; PG8_SCHED;
            PG8_STAGE(PG8_SB(1, 1), b3 + hstepB, voffB);
            PG8_WAIT_V(6); PG8_BAR; PG8_MMA(1, 1, At, B1); PG8_BAR;
            }
        }
        if constexpr (ALIGN_EPI) { if (wr == 0) PG8_BAR; }
        if constexpr (!Epi::AFTER_DRAIN) { E(acc, cur, wr, wc, fr, fq); S.done(cur); }
        if (!has_next) break;
#pragma unroll
        for (int a = 0; a < 2; ++a)
#pragma unroll
            for (int b = 0; b < 2; ++b)
#pragma unroll
                for (int m = 0; m < 4; ++m)
#pragma unroll
                    for (int n = 0; n < 2; ++n) acc[a][b][m][n] = (f32x4){0.f, 0.f, 0.f, 0.f};
        cur = nxt; cA = nA; cB = nB; ++ui;
        if constexpr (ALIGN_EPI) { if (wr == 1) PG8_BAR; }
    }
    PG8_WAIT_V(0);
    if constexpr (!ALIGN_EPI) { if (wr == 0) PG8_BAR; }
    PG8_BAR;
    if constexpr (Epi::AFTER_DRAIN) { E.fused(acc, cur, wr, wc, fr, fq, lds, wid, lane); S.done(cur); }
#undef PG8_SA
#undef PG8_SB
#undef PG8_STAGE
#undef PG8_LDA
#undef PG8_LDB
#undef PG8_MMA
#undef PG8_WAIT_V
#undef PG8_WAIT_L
#undef PG8_BAR
#undef PG8_SCHED
}
}

#define LAS __attribute__((address_space(3)))
using pg8::bf16_t; using pg8::f32x4; using pg8::u32x4; using pg8::bf16x8; using pg8::Unit; using pg8::BM; using pg8::HALF;
typedef unsigned u32x2 __attribute__((ext_vector_type(2)));

constexpr int MROWS = 32768, DM = 1024, SEQ = 8192, NBATCH = 4, DFF = 2816;
constexpr int NCHUNK = MROWS / 64;
constexpr float EPS = 1e-6f;
constexpr float QSCALE = 0.07216878364870322f * 1.4426950408889634f;
constexpr int N1 = 3840, NGATE = 2048, NUQ = 1536, NUKV = 2048, NGU = 5632;
constexpr size_t MiB = 1u << 20;
constexpr size_t WS_SS = 488 * MiB;
constexpr size_t WS_CD = 3 * MiB;
constexpr size_t WS_COS = 4 * MiB, WS_SIN = 8 * MiB;
constexpr size_t WS_WB = 12 * MiB;
constexpr size_t WS_H = 52 * MiB;
constexpr size_t WS_QG = 116 * MiB, WS_KG = 148 * MiB;
constexpr size_t WS_V = 180 * MiB;
constexpr size_t WS_G = 244 * MiB;
constexpr size_t WS_MQ = 308 * MiB, WS_QR = 372 * MiB;
constexpr size_t WS_KDT = 404 * MiB;
constexpr size_t WS_MISC = 436 * MiB;
constexpr size_t WS_CKV = 468 * MiB;
constexpr size_t WS_KPE = 484 * MiB;
constexpr size_t WS_END = 504 * MiB;
constexpr size_t WO_W1 = 0, WO_GATE = WO_W1 + (size_t)N1 * 1024, WO_UQ = WO_GATE + (size_t)NGATE * 1024, WO_UKV = WO_UQ + (size_t)NUQ * 512,
                 WO_OGLA = WO_UKV + (size_t)NUKV * 256, WO_OMLA = WO_OGLA + 1024 * 1024, WO_OUT = WO_OMLA + 1024 * 1024, WO_GU = WO_OUT + 1024 * 1024,
                 WO_DOWN = WO_GU + (size_t)NGU * 1024, WO_END = WO_DOWN + (size_t)1024 * DFF;
static_assert(WO_END * 2 <= 40 * MiB, "weights fit");

typedef float f32x2_t __attribute__((ext_vector_type(2))); typedef __bf16 bf16x2_t __attribute__((ext_vector_type(2)));
__device__ __forceinline__ unsigned pk2(float lo, float hi) { f32x2_t v = {lo, hi}; bf16x2_t b = __builtin_convertvector(v, bf16x2_t); return __builtin_bit_cast(unsigned, b); }
__device__ __forceinline__ u32x4 pack8(const f32x4 a, const f32x4 b) { u32x4 w; w.x = pk2(a[0], a[1]); w.y = pk2(a[2], a[3]); w.z = pk2(b[0], b[1]); w.w = pk2(b[2], b[3]); return w; }
__device__ __forceinline__ float bf_lo(unsigned w) { return __uint_as_float(w << 16); }
__device__ __forceinline__ float bf_hi(unsigned w) { return __uint_as_float(w & 0xffff0000u); }
__device__ __forceinline__ float bf1(bf16_t v) { return __uint_as_float(((unsigned)v) << 16); }
__device__ __forceinline__ float sigm(float x) { return __builtin_amdgcn_rcpf(1.f + __builtin_amdgcn_exp2f(x * -1.4426950408889634f)); }
__device__ __forceinline__ float wave_sum(float v) {
#pragma unroll
    for (int o = 1; o < 64; o <<= 1) v += __shfl_xor(v, o);
    return v;
}
__device__ __forceinline__ float dot4(const f32x4 a) { return (a[0] * a[0] + a[1] * a[1]) + (a[2] * a[2] + a[3] * a[3]); }

typedef f32x4 acc_t[2][2][4][2];

struct EpiG1 {
    static constexpr bool PERM = true, AFTER_DRAIN = false;
    bf16_t *Qg, *Kg, *V, *G, *CKV, *MISC; float *SSQ, *SSKV;
    __device__ __forceinline__ void operator()(const acc_t& acc, const Unit& u, int wr, int wc, int fr, int fq) const {
        const int pn = u.pn; bf16_t* base; int ld, c0;
        if (pn < 2) { base = Qg; ld = 512; c0 = pn * 256; }
        else if (pn < 4) { base = Kg; ld = 512; c0 = (pn - 2) * 256; }
        else if (pn < 8) { base = V; ld = 1024; c0 = (pn - 4) * 256; }
        else if (pn < 12) { base = G; ld = 1024; c0 = (pn - 8) * 256; }
        else if (pn == 12) { base = CKV; ld = 256; c0 = 0; }
        else { base = MISC; ld = 512; c0 = (pn - 13) * 256; }
        float* ssp = (pn == 12) ? (SSKV + wc) : ((pn >= 13) ? (SSQ + (pn - 13) * 4 + wc) : nullptr); const int sst = (pn == 12) ? 4 : 8;
        const bool both = (pn != 14);
        const int row0 = u.pm * BM + wr * 64 + fr, tc = wc * 32 + 8 * fq;
#pragma unroll
        for (int ai = 0; ai < 2; ++ai)
#pragma unroll
            for (int m = 0; m < 4; ++m) {
                const int row = row0 + ai * HALF + m * 16; bf16_t* rowp = base + (size_t)row * ld + c0 + tc; bf16_t* rowp1 = rowp + HALF;
                if (pn < 2) {
                    const int t = row & 63, ck = row >> 6;
#pragma unroll
                    for (int bj = 0; bj < 2; ++bj) { const int c = c0 + tc + bj * HALF, hh = c >> 7, j8 = (c & 127) >> 3, L = ((((t >> 4) * 4 + (j8 >> 2)) * 4 + (j8 & 3)) * 16 + (t & 15)) * 8;
                        bf16_t* p = Qg + (size_t)(ck * 64 + (L >> 7)) * 512 + hh * 128 + (L & 127); if (bj == 0) rowp = p; else rowp1 = p; }
                } else if (pn >= 4 && pn < 8) {
                    const int b_ = row >> 13, t = row & (SEQ - 1);
#pragma unroll
                    for (int bj = 0; bj < 2; ++bj) { const int c = c0 + tc + bj * HALF, hh = c >> 8, dvv = c & 255;
                        bf16_t* p = V + ((size_t)(((b_ * 4 + hh) * 16 + (dvv >> 4))) * SEQ + t) * 16 + (dvv & 8); if (bj == 0) rowp = p; else rowp1 = p; }
                }
                *(u32x4*)(rowp) = pack8(acc[ai][0][m][0], acc[ai][0][m][1]);
                *(u32x4*)(rowp1) = pack8(acc[ai][1][m][0], acc[ai][1][m][1]);
                if (ssp) {
                    float s = dot4(acc[ai][0][m][0]) + dot4(acc[ai][0][m][1]);
                    if (both) s += dot4(acc[ai][1][m][0]) + dot4(acc[ai][1][m][1]);
                    s += __shfl_xor(s, 16); s += __shfl_xor(s, 32);
                    if (fq == 0) ssp[(size_t)row * sst] = s;
                }
            }
    }
};
struct EpiQ {
    static constexpr bool PERM = true, AFTER_DRAIN = false;
    bf16_t *QN, *QR; const float* SSQ;
    __device__ __forceinline__ void operator()(const acc_t& acc, const Unit& u, int wr, int wc, int fr, int fq) const {
        const int pn = u.pn, row0 = u.pm * BM + wr * 64 + fr; bf16_t* base = (pn < 4) ? QN : QR; const int sh = (pn < 4) ? 10 : 9; const int c0 = (pn & 3) * 256 + wc * 32 + 8 * fq;
#pragma unroll
        for (int ai = 0; ai < 2; ++ai)
#pragma unroll
            for (int m = 0; m < 4; ++m) {
                const int row = row0 + ai * HALF + m * 16; const f32x4 q0 = *(const f32x4*)(SSQ + (size_t)row * 8), q1 = *(const f32x4*)(SSQ + (size_t)row * 8 + 4);
                const float rs = rsqrtf((((q0[0] + q0[1]) + (q0[2] + q0[3])) + ((q1[0] + q1[1]) + (q1[2] + q1[3]))) * (1.f / 384.f) + EPS) * QSCALE;
                bf16_t* rowp = base + ((size_t)row << sh) + c0;
                *(u32x4*)(rowp) = pack8(acc[ai][0][m][0] * rs, acc[ai][0][m][1] * rs);
                *(u32x4*)(rowp + HALF) = pack8(acc[ai][1][m][0] * rs, acc[ai][1][m][1] * rs);
                asm volatile("" ::: "memory");
            }
    }
};
struct EpiKV {
    static constexpr bool PERM = true, AFTER_DRAIN = false;
    bf16_t *KN, *VV; const float* SSKV;
    __device__ __forceinline__ void operator()(const acc_t& acc, const Unit& u, int wr, int wc, int fr, int fq) const {
        const int pn = u.pn, row0 = u.pm * BM + wr * 64 + fr; bf16_t* base = (pn < 4) ? KN : VV; const int c0 = (pn & 3) * 256 + wc * 32 + 8 * fq;
#pragma unroll
        for (int ai = 0; ai < 2; ++ai)
#pragma unroll
            for (int m = 0; m < 4; ++m) {
                const int row = row0 + ai * HALF + m * 16; const f32x4 q0 = *(const f32x4*)(SSKV + (size_t)row * 4); const float rs = rsqrtf(((q0[0] + q0[1]) + (q0[2] + q0[3])) * (1.f / 256.f) + EPS);
                bf16_t* rowp = base + (size_t)row * 1024 + c0;
                *(u32x4*)(rowp) = pack8(acc[ai][0][m][0] * rs, acc[ai][0][m][1] * rs);
                *(u32x4*)(rowp + HALF) = pack8(acc[ai][1][m][0] * rs, acc[ai][1][m][1] * rs);
                asm volatile("" ::: "memory");
            }
    }
};
template <bool SS> struct EpiStore {
    static constexpr bool PERM = true, AFTER_DRAIN = false;
    bf16_t* O; int ldc; float* ssp;
    __device__ __forceinline__ void operator()(const acc_t& acc, const Unit& u, int wr, int wc, int fr, int fq) const {
        const int row0 = u.pm * BM + wr * 64 + fr, c0 = u.pn * 256 + wc * 32 + 8 * fq;
#pragma unroll
        for (int ai = 0; ai < 2; ++ai)
#pragma unroll
            for (int m = 0; m < 4; ++m) {
                const int row = row0 + ai * HALF + m * 16; bf16_t* rowp = O + (size_t)row * ldc + c0;
                *(u32x4*)(rowp) = pack8(acc[ai][0][m][0], acc[ai][0][m][1]);
                *(u32x4*)(rowp + HALF) = pack8(acc[ai][1][m][0], acc[ai][1][m][1]);
                if (SS) {
                    float s = dot4(acc[ai][0][m][0]) + dot4(acc[ai][0][m][1]) + dot4(acc[ai][1][m][0]) + dot4(acc[ai][1][m][1]);
                    s += __shfl_xor(s, 16); s += __shfl_xor(s, 32);
                    if (fq == 0) ssp[(size_t)row * 16 + u.pn * 4 + wc] = s;
                }
            }
    }
};
struct EpiMerge {
    static constexpr bool PERM = true, AFTER_DRAIN = false;
    const bf16_t *YA, *YB; const float* bg; bf16_t* MIX;
    __device__ __forceinline__ void operator()(const acc_t& acc, const Unit& u, int wr, int wc, int fr, int fq) const {
        const int row0 = u.pm * BM + wr * 64 + fr, ch = u.pn * 128 + wc * 32 + 8 * fq;
        const f32x4 ba0 = *(const f32x4*)(bg + ch), ba1 = *(const f32x4*)(bg + ch + 4), bb0 = *(const f32x4*)(bg + 1024 + ch), bb1 = *(const f32x4*)(bg + 1024 + ch + 4);
#pragma unroll
        for (int ai = 0; ai < 2; ++ai)
#pragma unroll
            for (int m = 0; m < 4; ++m) {
                const size_t off = (size_t)(row0 + ai * HALF + m * 16) * 1024 + ch;
                const u32x4 ya = *(const u32x4*)(YA + off), yb = *(const u32x4*)(YB + off);
                const f32x4 ga0 = acc[ai][0][m][0] + ba0, ga1 = acc[ai][0][m][1] + ba1, gb0 = acc[ai][1][m][0] + bb0, gb1 = acc[ai][1][m][1] + bb1;
                f32x4 o0, o1;
                o0[0] = sigm(ga0[0]) * bf_lo(ya.x) + sigm(gb0[0]) * bf_lo(yb.x); o0[1] = sigm(ga0[1]) * bf_hi(ya.x) + sigm(gb0[1]) * bf_hi(yb.x);
                o0[2] = sigm(ga0[2]) * bf_lo(ya.y) + sigm(gb0[2]) * bf_lo(yb.y); o0[3] = sigm(ga0[3]) * bf_hi(ya.y) + sigm(gb0[3]) * bf_hi(yb.y);
                o1[0] = sigm(ga1[0]) * bf_lo(ya.z) + sigm(gb1[0]) * bf_lo(yb.z); o1[1] = sigm(ga1[1]) * bf_hi(ya.z) + sigm(gb1[1]) * bf_hi(yb.z);
                o1[2] = sigm(ga1[2]) * bf_lo(ya.w) + sigm(gb1[2]) * bf_lo(yb.w); o1[3] = sigm(ga1[3]) * bf_hi(ya.w) + sigm(gb1[3]) * bf_hi(yb.w);
                *(u32x4*)(MIX + off) = pack8(o0, o1);
                asm volatile("" ::: "memory");
            }
    }
};
struct EpiSwiglu {
    static constexpr bool PERM = true, AFTER_DRAIN = false;
    bf16_t* HID;
    __device__ __forceinline__ void operator()(const acc_t& acc, const Unit& u, int wr, int wc, int fr, int fq) const {
        const int row0 = u.pm * BM + wr * 64 + fr, ch = u.pn * 128 + wc * 32 + 8 * fq;
#pragma unroll
        for (int ai = 0; ai < 2; ++ai)
#pragma unroll
            for (int m = 0; m < 4; ++m) {
                f32x4 o0, o1;
#pragma unroll
                for (int e = 0; e < 4; ++e) { const float g0 = acc[ai][0][m][0][e], g1 = acc[ai][0][m][1][e];
                    o0[e] = g0 * sigm(g0) * acc[ai][1][m][0][e]; o1[e] = g1 * sigm(g1) * acc[ai][1][m][1][e]; }
                *(u32x4*)(HID + (size_t)(row0 + ai * HALF + m * 16) * DFF + ch) = pack8(o0, o1);
            }
    }
};
template <class Epi> __device__ __forceinline__ void run_gemm(LAS unsigned char* lds, const bf16_t* A, int lda, const bf16_t* Bt, int N, int K, const Epi& E) {
    pg8::Gemm g{A, Bt, MROWS, N, K, lda}; pg8::StaticOrder S; S.init(MROWS, N, (int)gridDim.x, (int)blockIdx.x);
    pg8::gemm_phase<Epi, pg8::StaticOrder, true, true>(lds, g, S, E);
}

__device__ __forceinline__ void transpose_item(const float* W, int ldw, int col0, int nvalid, const float* kg, bf16_t* WT, int K, int drow0, int k0, LAS float* scr, int lane) {
#pragma unroll
    for (int i = 0; i < 8; ++i) { const int kk = 8 * i + (lane >> 3), c = 4 * (lane & 7);
        f32x4 v = (c < nvalid) ? *(const f32x4*)(W + (size_t)(k0 + kk) * ldw + col0 + c) : (f32x4){0.f, 0.f, 0.f, 0.f}; if (kg) v = v * kg[k0 + kk];
        LAS float* d = scr + kk * 33 + c; d[0] = v[0]; d[1] = v[1]; d[2] = v[2]; d[3] = v[3]; }
    asm volatile("s_waitcnt lgkmcnt(0)" ::: "memory");
    const int c8 = lane & 7;
#pragma unroll
    for (int j = 0; j < 4; ++j) { const int n = (lane >> 3) + 8 * j; const LAS float* s = scr + (8 * c8) * 33 + n;
        u32x4 o; o.x = pk2(s[0 * 33], s[1 * 33]); o.y = pk2(s[2 * 33], s[3 * 33]); o.z = pk2(s[4 * 33], s[5 * 33]); o.w = pk2(s[6 * 33], s[7 * 33]);
        *(u32x4*)(WT + (size_t)(drow0 + n) * K + k0 + 8 * c8) = o; }
    asm volatile("s_waitcnt lgkmcnt(0)" ::: "memory");
}
struct Ins { const float *x; const int* pos; const float *pre_mix, *w_in, *w_a2, *b_a2, *gla_norm, *w_o_gla, *q_norm, *w_uq, *kv_norm, *w_ukv, *w_o_mla, *w_gate, *b_gate, *w_out,
             *post_mix, *pre_ffn, *w_fg, *w_fu, *w_fd, *post_ffn; };
constexpr int IT_W1 = (N1 / 32) * 16, IT_GATE = (NGATE / 32) * 16, IT_UQ = (NUQ / 32) * 8, IT_UKV = (NUKV / 32) * 4, IT_SQ = 32 * 16, IT_GU = (NGU / 32) * 16, IT_DOWN = 32 * 44;
constexpr int IT_TOTAL = IT_W1 + IT_GATE + IT_UQ + IT_UKV + 3 * IT_SQ + IT_GU + IT_DOWN;
__device__ __forceinline__ void weight_item(int it, const Ins& I, bf16_t* WB, LAS float* scr, int lane) {
    int r = it;
    if (r < IT_W1) { const int g = r / 16, kb = r % 16, n0 = g * 32; int col, nv = 32;
        if (n0 < 3072) col = n0; else if (n0 < 3328) col = 3472 + (n0 - 3072); else if (n0 < 3712) col = 3088 + (n0 - 3328); else if (n0 < 3776) col = 3728 + (n0 - 3712);
        else if (n0 == 3776) { col = 3072; nv = 16; } else { col = 0; nv = 0; }
        transpose_item(I.w_in, 3792, col, nv, nullptr, WB + WO_W1, 1024, n0, kb * 64, scr, lane); return; }
    r -= IT_W1;
    if (r < IT_GATE) { const int g = r / 16, kb = r % 16, n0 = g * 32, t = n0 >> 8, wi = n0 & 255; const int col = (wi < 128) ? (128 * t + wi) : (1024 + 128 * t + wi - 128);
        transpose_item(I.w_gate, 2048, col, 32, nullptr, WB + WO_GATE, 1024, n0, kb * 64, scr, lane); return; }
    r -= IT_GATE;
    if (r < IT_UQ) { const int g = r / 8, kb = r % 8, n0 = g * 32; int col;
        if (n0 < 1024) col = (n0 >> 7) * 192 + (n0 & 127); else { const int q = n0 - 1024; col = (q >> 6) * 192 + 128 + (q & 63); }
        if (kb < 6) transpose_item(I.w_uq, 1536, col, 32, I.q_norm, WB + WO_UQ, 512, n0, kb * 64, scr, lane); else transpose_item(I.w_uq, 1536, col, 0, nullptr, WB + WO_UQ, 512, n0, kb * 64, scr, lane); return; }
    r -= IT_UQ;
    if (r < IT_UKV) { const int g = r / 4, kb = r % 4, n0 = g * 32; const int q = n0 & 1023, col = (q >> 7) * 256 + (n0 >= 1024 ? 128 : 0) + (q & 127);
        transpose_item(I.w_ukv, 2048, col, 32, I.kv_norm, WB + WO_UKV, 256, n0, kb * 64, scr, lane); return; }
    r -= IT_UKV;
    if (r < IT_SQ) { const int g = r / 16, kb = r % 16; transpose_item(I.w_o_gla, 1024, g * 32, 32, nullptr, WB + WO_OGLA, 1024, g * 32, kb * 64, scr, lane); return; }
    r -= IT_SQ;
    if (r < IT_SQ) { const int g = r / 16, kb = r % 16; transpose_item(I.w_o_mla, 1024, g * 32, 32, nullptr, WB + WO_OMLA, 1024, g * 32, kb * 64, scr, lane); return; }
    r -= IT_SQ;
    if (r < IT_SQ) { const int g = r / 16, kb = r % 16; transpose_item(I.w_out, 1024, g * 32, 32, nullptr, WB + WO_OUT, 1024, g * 32, kb * 64, scr, lane); return; }
    r -= IT_SQ;
    if (r < IT_GU) { const int g = r / 16, kb = r % 16, n0 = g * 32, t = n0 >> 8, wi = n0 & 255;
        if (wi < 128) transpose_item(I.w_fg, DFF, 128 * t + wi, 32, nullptr, WB + WO_GU, 1024, n0, kb * 64, scr, lane); else transpose_item(I.w_fu, DFF, 128 * t + wi - 128, 32, nullptr, WB + WO_GU, 1024, n0, kb * 64, scr, lane); return; }
    r -= IT_GU;
    { const int g = r / 44, kb = r % 44; transpose_item(I.w_fd, 1024, g * 32, 32, nullptr, WB + WO_DOWN, DFF, g * 32, kb * 64, scr, lane); }
}
__device__ __forceinline__ void rms_row_to_bf16(const float* xrow, const float* gain, bf16_t* orow, int lane) {
    const f32x4* xr = (const f32x4*)xrow + lane; const f32x4* gr = (const f32x4*)gain + lane;
    f32x4 v[4]; float s = 0.f;
#pragma unroll
    for (int j = 0; j < 4; ++j) { v[j] = xr[64 * j]; s += dot4(v[j]); }
    const float rs = rsqrtf(wave_sum(s) * (1.f / 1024.f) + EPS);
    u32x2* o8 = (u32x2*)orow + lane;
#pragma unroll
    for (int j = 0; j < 4; ++j) { const f32x4 g = gr[64 * j]; u32x2 w; w.x = pk2(v[j][0] * rs * g[0], v[j][1] * rs * g[1]); w.y = pk2(v[j][2] * rs * g[2], v[j][3] * rs * g[3]); o8[64 * j] = w; }
}

__device__ __forceinline__ void gla_prep_item(int item, const bf16_t* Kg, const bf16_t* MISC, const float* w_a2, const float* b_a2, bf16_t* KDT, float* CD, LAS float* part) {
    int tid_ = threadIdx.x; asm volatile("" : "+v"(tid_));
    const int tid = tid_, j = tid & 127, tg = tid >> 7, cgi = item >> 2, h = item & 3, r0 = cgi * 64;
    float w[16];
#pragma unroll
    for (int r = 0; r < 16; ++r) w[r] = w_a2[r * 512 + h * 128 + j];
    const float bias = b_a2[h * 128 + j];
    float bcum[16]; float cum = 0.f;
#pragma unroll
    for (int tt = 0; tt < 16; ++tt) {
        const int row = r0 + tg * 16 + tt;
        const u32x4 ha0 = *(const u32x4*)(MISC + (size_t)row * 512 + 448), ha1 = *(const u32x4*)(MISC + (size_t)row * 512 + 456);
        float z = bias;
        z += bf_lo(ha0.x) * w[0] + bf_hi(ha0.x) * w[1] + bf_lo(ha0.y) * w[2] + bf_hi(ha0.y) * w[3] + bf_lo(ha0.z) * w[4] + bf_hi(ha0.z) * w[5] + bf_lo(ha0.w) * w[6] + bf_hi(ha0.w) * w[7];
        z += bf_lo(ha1.x) * w[8] + bf_hi(ha1.x) * w[9] + bf_lo(ha1.y) * w[10] + bf_hi(ha1.y) * w[11] + bf_lo(ha1.z) * w[12] + bf_hi(ha1.z) * w[13] + bf_lo(ha1.w) * w[14] + bf_hi(ha1.w) * w[15];
        const float ls = fminf(z, 0.f) - __logf(1.f + __expf(-fabsf(z)));
        cum += ls * (1.f / 16.f); bcum[tt] = cum;
    }
    part[tg * 128 + j] = cum;
    __syncthreads();
    const float p0 = part[j], p1 = part[128 + j], p2 = part[256 + j], p3 = part[384 + j];
    const float off = (tg > 0 ? p0 : 0.f) + (tg > 1 ? p1 : 0.f) + (tg > 2 ? p2 : 0.f), total = (p0 + p1) + (p2 + p3);
    unsigned pk[8];
#pragma unroll
    for (int tt = 0; tt < 16; tt += 2) {
        const int row = r0 + tg * 16 + tt;
        const float k0 = bf1(Kg[(size_t)row * 512 + h * 128 + j]) * __expf(total - (bcum[tt] + off));
        const float k1 = bf1(Kg[(size_t)(row + 1) * 512 + h * 128 + j]) * __expf(total - (bcum[tt + 1] + off));
        pk[tt >> 1] = pk2(k0, k1);
    }
    bf16_t* dst = KDT + (size_t)item * 8192 + (((((j >> 4) * 2 + (tg >> 1)) * 4 + (tg & 1) * 2) * 16 + (j & 15)) * 8);
    *(u32x4*)dst = (u32x4){pk[0], pk[1], pk[2], pk[3]}; *(u32x4*)(dst + 128) = (u32x4){pk[4], pk[5], pk[6], pk[7]};
    if (tg == 0) CD[(size_t)item * 128 + j] = __expf(total);
    __syncthreads();
}

struct GlaOps { bf16x8 a0, a1, vp, q0, q1, q2, q3; f32x4 d; };
__device__ __forceinline__ void gla_load(GlaOps& o, int cgi, int h, int s, int w, int fr, int fq, const bf16_t* Qg, const bf16_t* KDT, const float* CD, const bf16_t* Vb) {
    const int r0 = cgi * 64;
    const bf16_t* kdt = KDT + (size_t)(cgi * 4 + h) * 8192 + w * 1024 + fq * 128 + fr * 8;
    o.a0 = *(const bf16x8*)kdt; o.a1 = *(const bf16x8*)(kdt + 512);
    { const int cv = (cgi + 1 < (cgi | 127) ? cgi + 1 : (cgi | 127)), lv = (fq == 0) ? fr : 0;
      o.vp = *(const bf16x8*)(Vb + ((size_t)(((cgi >> 7) * 4 + h) * 16 + s) * SEQ + (size_t)(cv & 127) * 64) * 16 + w * 128 + lv * 8); }
    o.d = *(const f32x4*)(CD + (size_t)(cgi * 4 + h) * 128 + 16 * w + 4 * fq);
    const int fq2 = (w < 4) ? fq : 0, fr2 = (w < 4) ? fr : 0;
    const bf16_t* qp = Qg + (size_t)(r0 + 16 * (w & 3) + fq2) * 512 + h * 128 + fr2 * 8;
    o.q0 = *(const bf16x8*)qp; o.q1 = *(const bf16x8*)(qp + 4 * 512); o.q2 = *(const bf16x8*)(qp + 8 * 512); o.q3 = *(const bf16x8*)(qp + 12 * 512);
}
__device__ __forceinline__ void gla_step(const GlaOps& o, f32x4& S, int c, int w, int fr, int fq, LAS unsigned char* lds) {
    const LAS bf16_t* VL = (const LAS bf16_t*)(lds + 8704) + (c & 1) * 1024;
    typedef short v4i16_t __attribute__((ext_vector_type(4)));
    const LAS bf16_t* vtp = VL + (8 * fq + ((fr >> 2) & 3)) * 16 + (fr & 3) * 4;
    const v4i16_t t0 = __builtin_amdgcn_ds_read_tr16_b64_v4i16((LAS v4i16_t*)(vtp)), t1 = __builtin_amdgcn_ds_read_tr16_b64_v4i16((LAS v4i16_t*)(vtp + 64));
    const v4i16_t t2 = __builtin_amdgcn_ds_read_tr16_b64_v4i16((LAS v4i16_t*)(vtp + 512)), t3 = __builtin_amdgcn_ds_read_tr16_b64_v4i16((LAS v4i16_t*)(vtp + 576));
    const bf16x8 vb0 = {t0[0], t0[1], t0[2], t0[3], t1[0], t1[1], t1[2], t1[3]}, vb1 = {t2[0], t2[1], t2[2], t2[3], t3[0], t3[1], t3[2], t3[3]};
    S = S * o.d;
    S = __builtin_amdgcn_mfma_f32_16x16x32_bf16(o.a0, vb0, S, 0, 0, 0);
    S = __builtin_amdgcn_mfma_f32_16x16x32_bf16(o.a1, vb1, S, 0, 0, 0);
    LAS bf16_t* T = (LAS bf16_t*)lds + (c & 1) * (16 * 136);
    { u32x2 wv; wv.x = pk2(S[0], S[1]); wv.y = pk2(S[2], S[3]); *(LAS u32x2*)(T + fr * 136 + 16 * w + 4 * fq) = wv; }
    if (fq == 0) *(LAS bf16x8*)((LAS bf16_t*)(lds + 8704) + ((c + 1) & 1) * 1024 + w * 128 + fr * 8) = o.vp;
    __syncthreads();
    if (w < 4) {
        const LAS bf16_t* tp = T + fr * 136 + 8 * fq;
        const bf16x8 s0 = *(const LAS bf16x8*)tp, s1 = *(const LAS bf16x8*)(tp + 32), s2 = *(const LAS bf16x8*)(tp + 64), s3 = *(const LAS bf16x8*)(tp + 96);
        f32x4 v = {0.f, 0.f, 0.f, 0.f};
        v = __builtin_amdgcn_mfma_f32_16x16x32_bf16(o.q0, s0, v, 0, 0, 0);
        v = __builtin_amdgcn_mfma_f32_16x16x32_bf16(o.q1, s1, v, 0, 0, 0);
        v = __builtin_amdgcn_mfma_f32_16x16x32_bf16(o.q2, s2, v, 0, 0, 0);
        v = __builtin_amdgcn_mfma_f32_16x16x32_bf16(o.q3, s3, v, 0, 0, 0);
        v = v * 0.08838834764831845f;
        LAS bf16_t* OL = (LAS bf16_t*)(lds + 16384) + (c & 7) * 1024;
#pragma unroll
        for (int r = 0; r < 4; ++r) OL[(16 * w + 4 * fq + r) * 16 + fr] = (bf16_t)(pk2(v[r], 0.f) & 0xffffu);
    }
}
__device__ __forceinline__ void gla_flush(int c, int u, int tid, bf16_t* OGT, float* SSG, LAS unsigned char* lds) {
    __syncthreads();
    const size_t t0 = (size_t)u * SEQ + (size_t)(c - 7) * 64;
    const u32x4 v0 = *(const LAS u32x4*)(lds + 16384 + tid * 32), v1 = *(const LAS u32x4*)(lds + 16384 + tid * 32 + 16);
    *(u32x4*)(OGT + (t0 + tid) * 16) = v0; *(u32x4*)(OGT + (t0 + tid) * 16 + 8) = v1;
}
__device__ __forceinline__ void gla_unit(int u, const bf16_t* Qg, const bf16_t* KDT, const float* CD, const bf16_t* Vb, bf16_t* OGT, float* SSG, LAS unsigned char* lds) {
    int tid_ = threadIdx.x; asm volatile("" : "+v"(tid_));
    const int tid = tid_, lane = tid & 63, w = __builtin_amdgcn_readfirstlane(tid >> 6), fr = lane & 15, fq = lane >> 4;
    const int s = u & 15, h = (u >> 4) & 3, b = u >> 6;
    f32x4 S = {0.f, 0.f, 0.f, 0.f};
    GlaOps A, B, C, D;
    const int c0 = b * 128;
    gla_load(A, c0, h, s, w, fr, fq, Qg, KDT, CD, Vb); gla_load(B, c0 + 1, h, s, w, fr, fq, Qg, KDT, CD, Vb);
    gla_load(C, c0 + 2, h, s, w, fr, fq, Qg, KDT, CD, Vb); gla_load(D, c0 + 3, h, s, w, fr, fq, Qg, KDT, CD, Vb);
    { const int lv = (fq == 0) ? fr : 0;
      const bf16x8 v0 = *(const bf16x8*)(Vb + ((size_t)u * SEQ) * 16 + w * 128 + lv * 8);
      if (fq == 0) *(LAS bf16x8*)((LAS bf16_t*)(lds + 8704) + w * 128 + fr * 8) = v0; }
    __syncthreads();
    for (int c = 0; c < 128; c += 8) {
        const int n0 = c0 + c + 4, n1 = c0 + (c + 8 < 128 ? c + 8 : 124);
        gla_step(A, S, c, w, fr, fq, lds);     gla_load(A, n0, h, s, w, fr, fq, Qg, KDT, CD, Vb);
        gla_step(B, S, c + 1, w, fr, fq, lds); gla_load(B, n0 + 1, h, s, w, fr, fq, Qg, KDT, CD, Vb);
        gla_step(C, S, c + 2, w, fr, fq, lds); gla_load(C, n0 + 2, h, s, w, fr, fq, Qg, KDT, CD, Vb);
        gla_step(D, S, c + 3, w, fr, fq, lds); gla_load(D, n0 + 3, h, s, w, fr, fq, Qg, KDT, CD, Vb);
        gla_step(A, S, c + 4, w, fr, fq, lds); gla_load(A, n1, h, s, w, fr, fq, Qg, KDT, CD, Vb);
        gla_step(B, S, c + 5, w, fr, fq, lds); gla_load(B, n1 + 1, h, s, w, fr, fq, Qg, KDT, CD, Vb);
        gla_step(C, S, c + 6, w, fr, fq, lds); gla_load(C, n1 + 2, h, s, w, fr, fq, Qg, KDT, CD, Vb);
        gla_step(D, S, c + 7, w, fr, fq, lds); gla_load(D, n1 + 3, h, s, w, fr, fq, Qg, KDT, CD, Vb);
        gla_flush(c + 7, u, tid, OGT, SSG, lds);
    }
    __syncthreads();
}

namespace at {
using bf16 = bf16_t;
using s16x4 = __attribute__((ext_vector_type(4))) short;
using f32x16 = __attribute__((ext_vector_type(16))) float;
constexpr int KVBLK = 64;
constexpr float SCALE = 0.07216878364870322f;
constexpr float THR = 8.f;
constexpr int SHM_V = 64 * 128 * 2, SHM_K = 64 * 192 * 2, SHM_ATTN = 2 * SHM_V + 2 * SHM_K + 8 * 64 * 4;
#define KSWZ(row, colB) ((row) * 384 + ((colB) ^ ((((row) >> 1) & 7) << 4)))
#define SBAR() __builtin_amdgcn_sched_barrier(0)
__device__ __forceinline__ int crow(int r, int hi) { return (r & 3) + 8 * (r >> 2) + 4 * hi; }
__device__ __forceinline__ unsigned cvtpk(float lo, float hi) { unsigned r; asm volatile("v_cvt_pk_bf16_f32 %0, %1, %2" : "=v"(r) : "v"(lo), "v"(hi)); return r; }
template <bool FIRST> __device__ __forceinline__ void partialSM(f32x16& p0, f32x16& p1, float& m_ref, float& alpha) {
  constexpr float THRL = THR * 1.4426950408889634f;
  float pmax = p0[0];
#pragma unroll
  for (int r = 1; r < 16; ++r) pmax = fmaxf(pmax, p0[r]);
#pragma unroll
  for (int r = 0; r < 16; ++r) pmax = fmaxf(pmax, p1[r]);
  { auto rr = __builtin_amdgcn_permlane32_swap(__float_as_uint(pmax), __float_as_uint(pmax), false, false);
    pmax = fmaxf(__uint_as_float(rr[0]), __uint_as_float(rr[1])); }
  if (!FIRST && __builtin_expect(__all(pmax <= THRL), 1)) { alpha = 1.f; }
  else { const float d = FIRST ? pmax : fmaxf(pmax, 0.f); m_ref += d; alpha = FIRST ? 0.f : __builtin_amdgcn_exp2f(-d);
#pragma unroll
    for (int r = 0; r < 16; ++r) { p0[r] -= d; p1[r] -= d; } }
#pragma unroll
  for (int r = 0; r < 16; ++r) p0[r] = __builtin_amdgcn_exp2f(p0[r]);
}
__device__ __forceinline__ void finishSM(f32x16& p0, f32x16& p1, float alpha, float& l_reg, bf16x8& pa0, bf16x8& pa1, bf16x8& pa2, bf16x8& pa3) {
#pragma unroll
  for (int r = 0; r < 16; ++r) p1[r] = __builtin_amdgcn_exp2f(p1[r]);
  float ps = 0;
#pragma unroll
  for (int r = 0; r < 16; ++r) ps += p0[r];
#pragma unroll
  for (int r = 0; r < 16; ++r) ps += p1[r];
  { auto rr = __builtin_amdgcn_permlane32_swap(__float_as_uint(ps), __float_as_uint(ps), false, false);
    ps = __uint_as_float(rr[0]) + __uint_as_float(rr[1]); }
  l_reg = l_reg * alpha + ps;
#define PK4(P, BASE, OUT) do { unsigned a0 = cvtpk(P[BASE + 0], P[BASE + 1]), a1 = cvtpk(P[BASE + 2], P[BASE + 3]);   \
    unsigned b0 = cvtpk(P[BASE + 4], P[BASE + 5]), b1 = cvtpk(P[BASE + 6], P[BASE + 7]);                              \
    auto r0 = __builtin_amdgcn_permlane32_swap(a0, b0, false, false); auto r1 = __builtin_amdgcn_permlane32_swap(a1, b1, false, false); \
    u32x4 w = {r0[0], r1[0], r0[1], r1[1]}; OUT = *reinterpret_cast<bf16x8*>(&w); } while (0)
  PK4(p0, 0, pa0); PK4(p0, 8, pa1); PK4(p1, 0, pa2); PK4(p1, 8, pa3);
#undef PK4
}
__device__ __forceinline__ void qkt(f32x16& p0, f32x16& p1, const bf16* Ks, const bf16x8* qr, const char* Qs, int r32, int hi, bool visible, float m_ref) {
  const float init = visible ? -m_ref : -1e30f;
#pragma unroll
  for (int r = 0; r < 16; ++r) { p0[r] = init; p1[r] = init; }
#pragma unroll
  for (int d0 = 0; d0 < 12; ++d0) { int cb = (d0 * 16 + hi * 8) * 2;
    const bf16x8 qv = (d0 < 6) ? qr[d0 < 6 ? d0 : 0] : *reinterpret_cast<const bf16x8*>(Qs + (d0 - 6) * 1024);
    bf16x8 b0 = *reinterpret_cast<const bf16x8*>((const char*)Ks + KSWZ(r32, cb));
    bf16x8 b1 = *reinterpret_cast<const bf16x8*>((const char*)Ks + KSWZ(32 + r32, cb));
    p0 = __builtin_amdgcn_mfma_f32_32x32x16_bf16(b0, qv, p0, 0, 0, 0);
    p1 = __builtin_amdgcn_mfma_f32_32x32x16_bf16(b1, qv, p1, 0, 0, 0); }
}
__device__ __forceinline__ int v_st(int k, int c) { const int kk = (k & ~0xC) | ((k & 4) << 1) | ((k & 8) >> 1); return ((kk >> 3) * 4 + (c >> 5)) * 512 + ((kk & 7) * 32 + (c & 31)) * 2; }
__device__ __forceinline__ int v_rd_base(int lane) { return ((lane & 3) << 3) | (((lane >> 2) & 3) << 6) | (((lane >> 4) & 1) << 5) | (((lane >> 5) & 1) << 8); }
constexpr int v_rd_off(int d0, int ks, int half) { return d0 * 512 + ks * 4096 + half * 2048; }
template <int OFF> __device__ __forceinline__ s16x4 tr_read(int vb) {
  s16x4 r; asm volatile("ds_read_b64_tr_b16 %0, %1 offset:%2" : "=&v"(r) : "v"(vb), "i"(OFF) : "memory"); return r;
}
template <int D0> __device__ __forceinline__ void pv_one(f32x16& od, int vb, bf16x8 pa0, bf16x8 pa1, bf16x8 pa2, bf16x8 pa3) {
  const s16x4 l0 = tr_read<v_rd_off(D0, 0, 0)>(vb), h0 = tr_read<v_rd_off(D0, 0, 1)>(vb), l1 = tr_read<v_rd_off(D0, 1, 0)>(vb), h1 = tr_read<v_rd_off(D0, 1, 1)>(vb);
  const s16x4 l2 = tr_read<v_rd_off(D0, 2, 0)>(vb), h2 = tr_read<v_rd_off(D0, 2, 1)>(vb), l3 = tr_read<v_rd_off(D0, 3, 0)>(vb), h3 = tr_read<v_rd_off(D0, 3, 1)>(vb);
  asm volatile("s_waitcnt lgkmcnt(0)" ::: "memory"); SBAR();
#define PK(L, H) (bf16x8){L[0], L[1], L[2], L[3], H[0], H[1], H[2], H[3]}
  od = __builtin_amdgcn_mfma_f32_32x32x16_bf16(pa0, PK(l0, h0), od, 0, 0, 0);
  od = __builtin_amdgcn_mfma_f32_32x32x16_bf16(pa1, PK(l1, h1), od, 0, 0, 0);
  od = __builtin_amdgcn_mfma_f32_32x32x16_bf16(pa2, PK(l2, h2), od, 0, 0, 0);
  od = __builtin_amdgcn_mfma_f32_32x32x16_bf16(pa3, PK(l3, h3), od, 0, 0, 0);
#undef PK
}
__device__ __forceinline__ void pv_d0(f32x16* o, int vb, bf16x8 pa0, bf16x8 pa1, bf16x8 pa2, bf16x8 pa3) {
  pv_one<0>(o[0], vb, pa0, pa1, pa2, pa3); pv_one<1>(o[1], vb, pa0, pa1, pa2, pa3); pv_one<2>(o[2], vb, pa0, pa1, pa2, pa3); pv_one<3>(o[3], vb, pa0, pa1, pa2, pa3);
}
__device__ __forceinline__ void attn_unit(int b, int h, int qb, const bf16* QN, const bf16* QR, const float* COS, const float* SIN, const bf16* KN, const bf16* KPE, const bf16* VV, bf16* OM, char* lds) {
  int tid_ = threadIdx.x; asm volatile("" : "+v"(tid_));
  const int tid = tid_, wid = __builtin_amdgcn_readfirstlane(tid >> 6), lane = tid & 63, r32 = lane & 31, hi = lane >> 5;
  const long rowbase = (long)b * SEQ + (long)qb * 256;
  const bf16* Kh = KN + (long)b * SEQ * 1024 + h * 128; const bf16* Vh = VV + (long)b * SEQ * 1024 + h * 128; const bf16* Ph = KPE + (long)b * SEQ * 64;
  const int NT = 4 * qb + 4, vis = 4 * qb + (wid >> 1);
  bf16* V_lds = (bf16*)lds; bf16* K_lds = (bf16*)(lds + 2 * SHM_V);
  float* ws = (float*)(lds + 2 * SHM_V + 2 * SHM_K) + wid * 64; float* li_l = ws; float* al_l = ws + 32;
  float m_reg = 0.f, l_reg = 0; f32x16 o[4] = {}; bf16x8 qr[6];
  char* Qs = lds + SHM_ATTN + wid * 6144 + lane * 16;
  const bf16* Qw = QN + (rowbase + wid * 32 + r32) * 1024 + h * 128 + hi * 8; const bf16* Qw2 = QR + (rowbase + wid * 32 + r32) * 512 + h * 64 + hi * 8;
#pragma unroll
  for (int d0 = 0; d0 < 6; ++d0) qr[d0] = *reinterpret_cast<const bf16x8*>(Qw + d0 * 16);
#pragma unroll
  for (int d0 = 6; d0 < 8; ++d0) *reinterpret_cast<bf16x8*>(Qs + (d0 - 6) * 1024) = *reinterpret_cast<const bf16x8*>(Qw + d0 * 16);
#pragma unroll
  for (int g = 0; g < 2; ++g) {
    const u32x4 x1 = *reinterpret_cast<const u32x4*>(Qw2 + g * 16), x2 = *reinterpret_cast<const u32x4*>(Qw2 + 32 + g * 16);
    const float* cp = COS + (rowbase + wid * 32 + r32) * 32 + g * 16 + hi * 8; const float* sp = SIN + (rowbase + wid * 32 + r32) * 32 + g * 16 + hi * 8;
    const f32x4 c0 = *(const f32x4*)cp, c1 = *(const f32x4*)(cp + 4), s0 = *(const f32x4*)sp, s1 = *(const f32x4*)(sp + 4);
    const f32x4 a0 = {bf_lo(x1.x), bf_hi(x1.x), bf_lo(x1.y), bf_hi(x1.y)}, a1 = {bf_lo(x1.z), bf_hi(x1.z), bf_lo(x1.w), bf_hi(x1.w)};
    const f32x4 b0 = {bf_lo(x2.x), bf_hi(x2.x), bf_lo(x2.y), bf_hi(x2.y)}, b1 = {bf_lo(x2.z), bf_hi(x2.z), bf_lo(x2.w), bf_hi(x2.w)};
    *reinterpret_cast<u32x4*>(Qs + (2 + g) * 1024) = pack8(a0 * c0 - b0 * s0, a1 * c1 - b1 * s1);
    *reinterpret_cast<u32x4*>(Qs + (4 + g) * 1024) = pack8(b0 * c0 + a0 * s0, b1 * c1 + a1 * s1);
  }
  const int sr = tid >> 4, sc = (tid & 15) * 8, vst0 = v_st(sr, sc), vst1 = v_st(32 + sr, sc), pr = tid >> 3, pc = (tid & 7) * 8;
  const int vb0 = (int)(uintptr_t)V_lds + v_rd_base(lane);
  bf16x8 vs0, vs1, ks0, ks1, ks2;
#define SLOAD(k0) do { vs0 = *(const bf16x8*)(&Vh[(long)((k0) + sr) * 1024 + sc]); vs1 = *(const bf16x8*)(&Vh[(long)((k0) + 32 + sr) * 1024 + sc]); \
    ks0 = *(const bf16x8*)(&Kh[(long)((k0) + sr) * 1024 + sc]); ks1 = *(const bf16x8*)(&Kh[(long)((k0) + 32 + sr) * 1024 + sc]); \
    ks2 = *(const bf16x8*)(&Ph[(long)((k0) + pr) * 64 + pc]); } while (0)
#define SWRITE(bb) do { *(bf16x8*)((char*)V_lds + (bb) * SHM_V + vst0) = vs0; *(bf16x8*)((char*)V_lds + (bb) * SHM_V + vst1) = vs1; \
    *(bf16x8*)((char*)K_lds + (bb) * SHM_K + KSWZ(sr, sc * 2)) = ks0; *(bf16x8*)((char*)K_lds + (bb) * SHM_K + KSWZ(32 + sr, sc * 2)) = ks1; \
    *(bf16x8*)((char*)K_lds + (bb) * SHM_K + KSWZ(pr, (128 + pc) * 2)) = ks2; } while (0)
#define SWAIT() asm volatile("s_waitcnt vmcnt(0)" ::: "memory")
#define RESC(a) do { if (__any((a) < 1.f)) { if (hi == 0) al_l[r32] = (a); asm volatile("s_waitcnt lgkmcnt(0)" ::: "memory"); \
    _Pragma("unroll") for (int d = 0; d < 4; ++d) _Pragma("unroll") for (int r = 0; r < 16; ++r) o[d][r] *= al_l[crow(r, hi)]; } } while (0)
  f32x16 pA0, pA1, pB0, pB1; float alA, alB; bf16x8 pa0, pa1, pa2, pa3;
  SLOAD(0); SWAIT(); SWRITE(0); __syncthreads();
  qkt(pA0, pA1, K_lds, qr, Qs, r32, hi, true, 0.f); partialSM<true>(pA0, pA1, m_reg, alA);
  SLOAD(KVBLK);
  SWAIT(); SWRITE(1); __syncthreads();
  for (int j = 1; j + 1 < NT; j += 2) {
    SBAR(); SLOAD((j + 1) * KVBLK); SBAR();
    qkt(pB0, pB1, (bf16*)((char*)K_lds + SHM_K), qr, Qs, r32, hi, j <= vis, m_reg);
    finishSM(pA0, pA1, alA, l_reg, pa0, pa1, pa2, pa3); SBAR();
    pv_d0(o, vb0, pa0, pa1, pa2, pa3); partialSM<false>(pB0, pB1, m_reg, alB);
    __syncthreads(); SWAIT(); SWRITE(0);
    RESC(alB); __syncthreads();
    SBAR(); SLOAD((j + 2) * KVBLK); SBAR();
    qkt(pA0, pA1, K_lds, qr, Qs, r32, hi, j + 1 <= vis, m_reg);
    finishSM(pB0, pB1, alB, l_reg, pa0, pa1, pa2, pa3); SBAR();
    pv_d0(o, vb0 + (int)SHM_V, pa0, pa1, pa2, pa3); partialSM<false>(pA0, pA1, m_reg, alA);
    __syncthreads(); SWAIT(); SWRITE(1);
    RESC(alA); __syncthreads();
  }
  SBAR(); qkt(pB0, pB1, (bf16*)((char*)K_lds + SHM_K), qr, Qs, r32, hi, NT - 1 <= vis, m_reg);
  finishSM(pA0, pA1, alA, l_reg, pa0, pa1, pa2, pa3); SBAR();
  pv_d0(o, vb0, pa0, pa1, pa2, pa3); partialSM<false>(pB0, pB1, m_reg, alB);
  __syncthreads(); RESC(alB);
  finishSM(pB0, pB1, alB, l_reg, pa0, pa1, pa2, pa3); SBAR();
  pv_d0(o, vb0 + (int)SHM_V, pa0, pa1, pa2, pa3);
  if (hi == 0) li_l[r32] = l_reg; asm volatile("s_waitcnt lgkmcnt(0)" ::: "memory");
  float rli[16];
#pragma unroll
  for (int r = 0; r < 16; ++r) rli[r] = __builtin_amdgcn_rcpf(li_l[crow(r, hi)]);
  bf16* Ow = OM + (rowbase + wid * 32) * 1024 + h * 128;
#pragma unroll
  for (int r = 0; r < 16; ++r) { const int orow = crow(r, hi);
#pragma unroll
    for (int d0 = 0; d0 < 4; ++d0) Ow[(long)orow * 1024 + d0 * 32 + r32] = (bf16)(cvtpk(o[d0][r] * rli[r], 0.f) & 0xffffu); }
  __syncthreads();
#undef SLOAD
#undef SWRITE
#undef SWAIT
#undef RESC
}
#undef KSWZ
#undef SBAR
}

#define XB_TMO      128
#define XB_XCNT(j)  (256  + 64 * (j))
#define XB_XSUB(j)  (1280 + 64 * (j))
#define XB_XGEN(j)  (2304 + 64 * (j))
#define XB_TOP      3328
#define XB_TOPGEN   3392
#define XCD_BAR_WORDS 3456
#define XB_SPIN_CAP (1u << 18)

__device__ __forceinline__ unsigned xb_ld(unsigned* p)              { return __hip_atomic_load(p, __ATOMIC_RELAXED, __HIP_MEMORY_SCOPE_AGENT); }
__device__ __forceinline__ unsigned xb_add(unsigned* p, unsigned v) { return __hip_atomic_fetch_add(p, v, __ATOMIC_RELAXED, __HIP_MEMORY_SCOPE_AGENT); }
__device__ __forceinline__ unsigned xb_xcc_id() { return (unsigned)__builtin_amdgcn_s_getreg((3 << 11) | 20) & 0xFu; }
#define XB_SPIN(cond, bar) do { unsigned _sp = 0; while (cond) { __builtin_amdgcn_s_sleep(1); \
    if ((++_sp & 255u) == 0u) { if (xb_ld(&(bar)[XB_TMO])) break; if (_sp > XB_SPIN_CAP) { atomicAdd(&(bar)[XB_TMO], 1u); break; } } } } while (0)

struct XcdBarrier {
    unsigned* bar; unsigned x;
    volatile LAS unsigned* st;
};

__device__ __forceinline__ XcdBarrier xcd_barrier_post(unsigned* bar, volatile LAS unsigned* st) {
    XcdBarrier b; b.bar = bar; b.x = xb_xcc_id(); b.st = st;
    if (threadIdx.x == 0) (void)xb_add(&bar[XB_XCNT(b.x)], 1u);
    return b;
}
__device__ __forceinline__ void xcd_barrier_complete(unsigned* bar, unsigned x, unsigned& nloc, unsigned& nx) {
    const unsigned G = gridDim.x * gridDim.y * gridDim.z;
    unsigned sum, cnt, mine, sp = 0u;
    for (;;) {
        sum = 0u; cnt = 0u; mine = 0u;
#pragma unroll
        for (unsigned j = 0; j < 16; ++j) { const unsigned c = xb_ld(&bar[XB_XCNT(j)]); sum += c; cnt += (c > 0u) ? 1u : 0u; mine = (j == x) ? c : mine; }
        if (sum == G) break;
        __builtin_amdgcn_s_sleep(1);
        if ((++sp & 255u) == 0u) { if (xb_ld(&bar[XB_TMO])) break; if (sp > XB_SPIN_CAP) { atomicAdd(&bar[XB_TMO], 1u); break; } }
    }
    nloc = mine > 0u ? mine : 1u; nx = cnt > 0u ? cnt : 1u;
}

__device__ __forceinline__ void xcd_barrier(const XcdBarrier& b) {
    asm volatile("s_waitcnt vmcnt(0)" ::: "memory");
    __syncthreads();
    if (threadIdx.x == 0) {
        unsigned* bar = b.bar;
        __builtin_amdgcn_s_waitcnt(0);
        unsigned nloc = b.st[0], nx = b.st[1];
        if (nloc == 0u) { xcd_barrier_complete(bar, b.x, nloc, nx); b.st[0] = nloc; b.st[1] = nx; }
        const unsigned old = xb_add(&bar[XB_XSUB(b.x)], 1u);
        const unsigned gen = old / nloc;
        if (old + 1u == (gen + 1u) * nloc) {
            __builtin_amdgcn_fence(__ATOMIC_RELEASE, "agent");
            asm volatile("s_waitcnt vmcnt(0)" ::: "memory");
            const unsigned og = xb_add(&bar[XB_TOP], 1u);
            const unsigned tg = og / nx;
            if (og + 1u == (tg + 1u) * nx) xb_add(&bar[XB_TOPGEN], 1u);
            else XB_SPIN(xb_ld(&bar[XB_TOPGEN]) == tg, bar);
            __builtin_amdgcn_fence(__ATOMIC_ACQUIRE, "agent");
            xb_add(&bar[XB_XGEN(b.x)], 1u);
            asm volatile("s_waitcnt vmcnt(0)" ::: "memory");
        } else {
            XB_SPIN(xb_ld(&bar[XB_XGEN(b.x)]) == gen, bar);
            __builtin_amdgcn_fence(__ATOMIC_ACQUIRE, "agent");
            asm volatile("s_waitcnt vmcnt(0)" ::: "memory");
        }
    }
    __syncthreads();
}

constexpr int NPHASE = 13;
constexpr int IT_TAIL = 3072;
constexpr int LDS_BYTES = 147456;
struct Args { const void* in[22]; float* out; unsigned char* ws; int ph_lo, ph_hi, coop, pad; };

__global__ void __launch_bounds__(512, 2) fwd_kernel(Args a) {
    extern __shared__ __attribute__((aligned(16))) unsigned char lds_raw[];
    LAS unsigned char* lds = (LAS unsigned char*)lds_raw;
    const int wave = __builtin_amdgcn_readfirstlane(threadIdx.x >> 6);
#define PHASE_TID int tid = threadIdx.x; asm volatile("" : "+v"(tid)); const int lane = tid & 63; (void)lane;
    const int G = gridDim.x, bx = blockIdx.x, vcu = (G % 8 == 0) ? (bx % 8) * (G / 8) + bx / 8 : bx;
    const int gw = bx * 8 + wave, NGW = G * 8;
    unsigned char* ws = a.ws;
    Ins I;
    I.x = (const float*)a.in[0]; I.pos = (const int*)a.in[1]; I.pre_mix = (const float*)a.in[2]; I.w_in = (const float*)a.in[3]; I.w_a2 = (const float*)a.in[4]; I.b_a2 = (const float*)a.in[5];
    I.gla_norm = (const float*)a.in[6]; I.w_o_gla = (const float*)a.in[7]; I.q_norm = (const float*)a.in[8]; I.w_uq = (const float*)a.in[9]; I.kv_norm = (const float*)a.in[10];
    I.w_ukv = (const float*)a.in[11]; I.w_o_mla = (const float*)a.in[12]; I.w_gate = (const float*)a.in[13]; I.b_gate = (const float*)a.in[14]; I.w_out = (const float*)a.in[15];
    I.post_mix = (const float*)a.in[16]; I.pre_ffn = (const float*)a.in[17]; I.w_fg = (const float*)a.in[18]; I.w_fu = (const float*)a.in[19]; I.w_fd = (const float*)a.in[20]; I.post_ffn = (const float*)a.in[21];
    float* SS = (float*)(ws + WS_SS); float *SSQ = SS, *SSKV = SS + (size_t)8 * MROWS, *SSG = SS + (size_t)12 * MROWS, *SSY = SS + (size_t)76 * MROWS, *SSF = SS + (size_t)92 * MROWS;
    float* CD = (float*)(ws + WS_CD); float* COS = (float*)(ws + WS_COS); float* SIN = (float*)(ws + WS_SIN);
    bf16_t* WB = (bf16_t*)(ws + WS_WB); bf16_t* H = (bf16_t*)(ws + WS_H); bf16_t* Qg = (bf16_t*)(ws + WS_QG); bf16_t* Kg = (bf16_t*)(ws + WS_KG);
    bf16_t* Vb = (bf16_t*)(ws + WS_V); bf16_t* Gb = (bf16_t*)(ws + WS_G); bf16_t* MQ = (bf16_t*)(ws + WS_MQ); bf16_t* QR = (bf16_t*)(ws + WS_QR); bf16_t* OM = MQ; bf16_t* HID = MQ;
    bf16_t* KDT = (bf16_t*)(ws + WS_KDT); bf16_t* MISC = (bf16_t*)(ws + WS_MISC); bf16_t* CKV = (bf16_t*)(ws + WS_CKV); bf16_t* KPE = (bf16_t*)(ws + WS_KPE);
    bf16_t* KN = (bf16_t*)a.out; bf16_t* VV = KN + (size_t)MROWS * 1024; bf16_t* OGT = KN; bf16_t* YA = KN; bf16_t* YB = VV;
    bf16_t* MIX = Gb; bf16_t* Yo = Vb; bf16_t* Fo = Gb;
    const int lo = a.ph_lo, hi = a.ph_hi;
    volatile LAS unsigned* bst = (volatile LAS unsigned*)(lds + LDS_BYTES - 64);
    XcdBarrier xbar; xbar.bar = (unsigned*)ws; xbar.x = 0; xbar.st = bst;
    if (a.coop) { if (threadIdx.x < 2) bst[threadIdx.x] = 0u; __syncthreads(); xbar = xcd_barrier_post((unsigned*)ws, bst); }
#ifndef PH_MASK
#define PH_MASK 0x1FFF
#endif
#define IN(k) (((PH_MASK >> (k)) & 1) && lo <= (k) && (k) < hi)
#define SEAM(k) do { if (a.coop && IN(k) && IN((k) + 1)) { if (a.pad == 0x5eed) cg::this_grid().sync(); xcd_barrier(xbar); } } while (0)

    if (IN(0)) { PHASE_TID
        LAS float* scr = (LAS float*)(lds + wave * 16384);
        const int p1_units = (MROWS / 256) * (N1 / 256), p1_full = p1_units % G;
        const int it_p0 = (p1_full != 0) ? IT_TOTAL - IT_TAIL : IT_TOTAL;
        for (int it = gw; it < it_p0; it += NGW) weight_item(it, I, WB, scr, lane);
        for (int m = gw; m < MROWS; m += 4 * NGW) {
            const f32x4* gr = (const f32x4*)I.pre_mix + lane;
            f32x4 v[4][4]; float ss[4]; int mr[4];
#pragma unroll
            for (int r = 0; r < 4; ++r) { mr[r] = (m + r * NGW < MROWS) ? m + r * NGW : m; const f32x4* xa = (const f32x4*)(I.x + (size_t)mr[r] * DM) + lane;
#pragma unroll
                for (int j = 0; j < 4; ++j) v[r][j] = xa[64 * j]; }
#pragma unroll
            for (int r = 0; r < 4; ++r) { float s_ = 0.f;
#pragma unroll
                for (int j = 0; j < 4; ++j) s_ += dot4(v[r][j]);
                ss[r] = rsqrtf(wave_sum(s_) * (1.f / 1024.f) + EPS); }
#pragma unroll
            for (int r = 0; r < 4; ++r) { if (r == 0 || mr[r] != m) { u32x2* oa = (u32x2*)(H + (size_t)mr[r] * DM) + lane;
#pragma unroll
                for (int j = 0; j < 4; ++j) { const f32x4 g = gr[64 * j]; u32x2 w; w.x = pk2(v[r][j][0] * ss[r] * g[0], v[r][j][1] * ss[r] * g[1]); w.y = pk2(v[r][j][2] * ss[r] * g[2], v[r][j][3] * ss[r] * g[3]); oa[64 * j] = w; } } }
        }
        for (int i = bx * 512 + tid; i < MROWS * 32; i += G * 512) {
            const int row = i >> 5, f = i & 31;
            const float inv = __builtin_amdgcn_exp2f(-(float)f * (13.287712379549449f / 32.f));
            float rev = (float)I.pos[row] * inv * 0.15915494309189535f; rev -= rintf(rev);
            COS[i] = __builtin_amdgcn_cosf(rev); SIN[i] = __builtin_amdgcn_sinf(rev);
        }
    }
    SEAM(0);
    if (IN(1)) { PHASE_TID
        { EpiG1 E{Qg, Kg, Vb, Gb, CKV, MISC, SSQ, SSKV}; run_gemm(lds, H, 1024, WB + WO_W1, N1, 1024, E); }
        const int p1_units = (MROWS / 256) * (N1 / 256), p1_full = p1_units % G;
        if (p1_full != 0 && bx >= p1_full) {
            LAS float* scr = (LAS float*)(lds + wave * 16384); const int nsw = (G - p1_full) * 8, lw = (bx - p1_full) * 8 + wave;
            for (int it = IT_TOTAL - IT_TAIL + lw; it < IT_TOTAL; it += nsw) weight_item(it, I, WB, scr, lane);
        }
    }
    SEAM(1);
    if (IN(2)) { PHASE_TID
        for (int i = bx * 512 + tid; i < MROWS * 32; i += G * 512) {
            const int row = i >> 5, f = i & 31; const float c = COS[i], s = SIN[i];
            const float x1 = bf1(MISC[(size_t)row * 512 + 384 + f]), x2 = bf1(MISC[(size_t)row * 512 + 416 + f]);
            KPE[(size_t)row * 64 + f] = (bf16_t)(pk2(x1 * c - x2 * s, 0.f) & 0xffffu); KPE[(size_t)row * 64 + 32 + f] = (bf16_t)(pk2(x2 * c + x1 * s, 0.f) & 0xffffu);
        }
#ifndef SKIP_PREP
        for (int it = bx; it < NCHUNK * 4; it += G) gla_prep_item(it, Kg, MISC, I.w_a2, I.b_a2, KDT, CD, (LAS float*)lds);
#endif
        { EpiQ E{MQ, QR, SSQ}; run_gemm(lds, MISC, 512, WB + WO_UQ, NUQ, 512, E); }
#ifndef SKIP_KV
        { EpiKV E{KN, VV, SSKV}; run_gemm(lds, CKV, 256, WB + WO_UKV, NUKV, 256, E); }
#endif
    }
    SEAM(2);
    if (IN(3)) {
        for (int idx = vcu; idx < 1024; idx += G) {
            const int v = idx & 255, i = idx >> 8, s = v & 7, bh = v >> 3; const int qb = (i == 0) ? s : (i == 1) ? 15 - s : (i == 2) ? 16 + s : 31 - s;
            at::attn_unit(bh >> 3, bh & 7, qb, MQ, QR, COS, SIN, KN, KPE, VV, OM, (char*)lds_raw);
        }
    }
    SEAM(3);
    if (IN(4)) { for (int u = vcu; u < 256; u += G) gla_unit(u, Qg, KDT, CD, Vb, OGT, SSG, lds); }
    SEAM(4);
    if (IN(5)) { PHASE_TID
        for (int m = gw; m < MROWS; m += NGW) {
            bf16_t* orow = Vb + (size_t)m * 1024 + 16 * lane; const bf16_t* grow = Gb + (size_t)m * 1024 + 16 * lane;
            const bf16_t* irow = OGT + ((size_t)(((m >> 13) * 4 + (lane >> 4)) * 16 + (lane & 15)) * SEQ + (m & (SEQ - 1))) * 16;
            const u32x4 ovA = *(const u32x4*)(irow), ovB = *(const u32x4*)(irow + 8);
            float ssg = ((bf_lo(ovA.x) * bf_lo(ovA.x) + bf_hi(ovA.x) * bf_hi(ovA.x)) + (bf_lo(ovA.y) * bf_lo(ovA.y) + bf_hi(ovA.y) * bf_hi(ovA.y))) + ((bf_lo(ovA.z) * bf_lo(ovA.z) + bf_hi(ovA.z) * bf_hi(ovA.z)) + (bf_lo(ovA.w) * bf_lo(ovA.w) + bf_hi(ovA.w) * bf_hi(ovA.w)));
            ssg += ((bf_lo(ovB.x) * bf_lo(ovB.x) + bf_hi(ovB.x) * bf_hi(ovB.x)) + (bf_lo(ovB.y) * bf_lo(ovB.y) + bf_hi(ovB.y) * bf_hi(ovB.y))) + ((bf_lo(ovB.z) * bf_lo(ovB.z) + bf_hi(ovB.z) * bf_hi(ovB.z)) + (bf_lo(ovB.w) * bf_lo(ovB.w) + bf_hi(ovB.w) * bf_hi(ovB.w)));
            ssg += __shfl_xor(ssg, 1); ssg += __shfl_xor(ssg, 2); ssg += __shfl_xor(ssg, 4); ssg += __shfl_xor(ssg, 8);
            const float rs = rsqrtf(ssg * (1.f / 256.f) + EPS); const float* gn = I.gla_norm + 16 * (lane & 15);
#pragma unroll
            for (int k = 0; k < 2; ++k) {
                const u32x4 ov = *(const u32x4*)(irow + 8 * k), gv = *(const u32x4*)(grow + 8 * k); const f32x4 n0 = *(const f32x4*)(gn + 8 * k), n1 = *(const f32x4*)(gn + 8 * k + 4);
                f32x4 r0, r1; float g;
                g = bf_lo(gv.x); r0[0] = bf_lo(ov.x) * rs * n0[0] * g * sigm(g); g = bf_hi(gv.x); r0[1] = bf_hi(ov.x) * rs * n0[1] * g * sigm(g);
                g = bf_lo(gv.y); r0[2] = bf_lo(ov.y) * rs * n0[2] * g * sigm(g); g = bf_hi(gv.y); r0[3] = bf_hi(ov.y) * rs * n0[3] * g * sigm(g);
                g = bf_lo(gv.z); r1[0] = bf_lo(ov.z) * rs * n1[0] * g * sigm(g); g = bf_hi(gv.z); r1[1] = bf_hi(ov.z) * rs * n1[1] * g * sigm(g);
                g = bf_lo(gv.w); r1[2] = bf_lo(ov.w) * rs * n1[2] * g * sigm(g); g = bf_hi(gv.w); r1[3] = bf_hi(ov.w) * rs * n1[3] * g * sigm(g);
                *(u32x4*)(orow + 8 * k) = pack8(r0, r1);
            }
        }
        { EpiStore<false> E{YB, 1024, nullptr}; run_gemm(lds, OM, 1024, WB + WO_OMLA, 1024, 1024, E); }
    }
    SEAM(5);
    if (IN(6)) { EpiStore<false> E{YA, 1024, nullptr}; run_gemm(lds, Vb, 1024, WB + WO_OGLA, 1024, 1024, E); }
    SEAM(6);
    if (IN(7)) { EpiMerge E{YA, YB, I.b_gate, MIX}; run_gemm(lds, H, 1024, WB + WO_GATE, NGATE, 1024, E); }
    SEAM(7);
    if (IN(8)) { EpiStore<true> E{Yo, 1024, SSY}; run_gemm(lds, MIX, 1024, WB + WO_OUT, 1024, 1024, E); }
    SEAM(8);
    if (IN(9)) { PHASE_TID
        for (int m = gw; m < MROWS; m += NGW) {
            const f32x4* xr = (const f32x4*)(I.x + (size_t)m * DM) + lane; const u32x2* yr = (const u32x2*)(Yo + (size_t)m * DM) + lane;
            const f32x4* g1 = (const f32x4*)I.post_mix + lane; const f32x4* g2 = (const f32x4*)I.pre_ffn + lane;
            float ssm; { const f32x4* sp = (const f32x4*)(SSY + (size_t)m * 16); const f32x4 t0 = sp[0], t1 = sp[1], t2 = sp[2], t3 = sp[3];
                ssm = (((t0[0] + t0[1]) + (t0[2] + t0[3])) + ((t1[0] + t1[1]) + (t1[2] + t1[3]))) + (((t2[0] + t2[1]) + (t2[2] + t2[3])) + ((t3[0] + t3[1]) + (t3[2] + t3[3]))); }
            const float rs = rsqrtf(ssm * (1.f / 1024.f) + EPS);
            f32x4 v[4]; float s = 0.f;
#pragma unroll
            for (int j = 0; j < 4; ++j) { const f32x4 xv = xr[64 * j]; const u32x2 yv = yr[64 * j]; const f32x4 gv = g1[64 * j];
                v[j][0] = xv[0] + bf_lo(yv.x) * rs * gv[0]; v[j][1] = xv[1] + bf_hi(yv.x) * rs * gv[1]; v[j][2] = xv[2] + bf_lo(yv.y) * rs * gv[2]; v[j][3] = xv[3] + bf_hi(yv.y) * rs * gv[3];
                s += dot4(v[j]); }
            const float rs2 = rsqrtf(wave_sum(s) * (1.f / 1024.f) + EPS);
            u32x2* hrow = (u32x2*)(H + (size_t)m * DM) + lane;
#pragma unroll
            for (int j = 0; j < 4; ++j) { const f32x4 gv = g2[64 * j]; u32x2 w; w.x = pk2(v[j][0] * rs2 * gv[0], v[j][1] * rs2 * gv[1]); w.y = pk2(v[j][2] * rs2 * gv[2], v[j][3] * rs2 * gv[3]); hrow[64 * j] = w; }
        }
    }
    SEAM(9);
    if (IN(10)) { EpiSwiglu E{HID}; run_gemm(lds, H, 1024, WB + WO_GU, NGU, 1024, E); }
    SEAM(10);
    if (IN(11)) { EpiStore<true> E{Fo, 1024, SSF}; run_gemm(lds, HID, DFF, WB + WO_DOWN, 1024, DFF, E); }
    SEAM(11);
    if (IN(12)) { PHASE_TID
        for (int m = gw; m < MROWS; m += NGW) {
            f32x4* orow = (f32x4*)(a.out + (size_t)m * DM) + lane; const f32x4* xr = (const f32x4*)(I.x + (size_t)m * DM) + lane;
            const u32x2* yr = (const u32x2*)(Yo + (size_t)m * DM) + lane; const u32x2* fr_ = (const u32x2*)(Fo + (size_t)m * DM) + lane;
            const f32x4* g1 = (const f32x4*)I.post_mix + lane; const f32x4* g2 = (const f32x4*)I.post_ffn + lane;
            float ss1, ss2;
            { const f32x4* sp = (const f32x4*)(SSY + (size_t)m * 16); const f32x4 t0 = sp[0], t1 = sp[1], t2 = sp[2], t3 = sp[3];
              ss1 = (((t0[0] + t0[1]) + (t0[2] + t0[3])) + ((t1[0] + t1[1]) + (t1[2] + t1[3]))) + (((t2[0] + t2[1]) + (t2[2] + t2[3])) + ((t3[0] + t3[1]) + (t3[2] + t3[3]))); }
            { const f32x4* sp = (const f32x4*)(SSF + (size_t)m * 16); const f32x4 t0 = sp[0], t1 = sp[1], t2 = sp[2], t3 = sp[3];
              ss2 = (((t0[0] + t0[1]) + (t0[2] + t0[3])) + ((t1[0] + t1[1]) + (t1[2] + t1[3]))) + (((t2[0] + t2[1]) + (t2[2] + t2[3])) + ((t3[0] + t3[1]) + (t3[2] + t3[3]))); }
            const float rs1 = rsqrtf(ss1 * (1.f / 1024.f) + EPS), rs2 = rsqrtf(ss2 * (1.f / 1024.f) + EPS);
#pragma unroll
            for (int j = 0; j < 4; ++j) { const f32x4 xv = xr[64 * j]; const u32x2 yv = yr[64 * j], fv = fr_[64 * j]; const f32x4 ga = g1[64 * j], gb = g2[64 * j]; f32x4 o;
                o[0] = (xv[0] + bf_lo(yv.x) * rs1 * ga[0]) + bf_lo(fv.x) * rs2 * gb[0]; o[1] = (xv[1] + bf_hi(yv.x) * rs1 * ga[1]) + bf_hi(fv.x) * rs2 * gb[1];
                o[2] = (xv[2] + bf_lo(yv.y) * rs1 * ga[2]) + bf_lo(fv.y) * rs2 * gb[2]; o[3] = (xv[3] + bf_hi(yv.y) * rs1 * ga[3]) + bf_hi(fv.y) * rs2 * gb[3];
                orow[64 * j] = o; }
        }
    }
#undef IN
#undef SEAM
}


#ifdef DBG_STOP
__global__ void dbg_copy(unsigned char* ws, float* out) {
    const bf16_t* Vb = (const bf16_t*)(ws + WS_V); const bf16_t* Gb = (const bf16_t*)(ws + WS_G); const bf16_t* Qg = (const bf16_t*)(ws + WS_QG); const bf16_t* Kg = (const bf16_t*)(ws + WS_KG);
    const bf16_t* MISC = (const bf16_t*)(ws + WS_MISC); const bf16_t* CKV = (const bf16_t*)(ws + WS_CKV); const bf16_t* QN = (const bf16_t*)(ws + WS_MQ); const bf16_t* QR = (const bf16_t*)(ws + WS_QR);
    const bf16_t* KDT = (const bf16_t*)(ws + WS_KDT); const bf16_t* KPE = (const bf16_t*)(ws + WS_KPE); const bf16_t* KN = (const bf16_t*)out; const bf16_t* H = (const bf16_t*)(ws + WS_H);
    const float* CD = (const float*)(ws + WS_CD);
    for (size_t i = (size_t)blockIdx.x * blockDim.x + threadIdx.x; i < (size_t)MROWS * 1024; i += (size_t)gridDim.x * blockDim.x) {
        const size_t row = i >> 10, c = i & 1023; float v = 0.f;
#if DBG_STOP == 1
        v = bf1(Vb[i]) + bf1(Gb[i]) + bf1(Qg[row * 512 + (c & 511)]) + bf1(Kg[row * 512 + (c & 511)]) + bf1(MISC[row * 512 + (c & 511)]) + bf1(CKV[row * 256 + (c & 255)]) + bf1(H[i]);
#elif DBG_STOP == 2
        v = bf1(QN[i]) + bf1(QR[row * 512 + (c & 511)]) + bf1(KPE[row * 64 + (c & 63)]) + bf1(KDT[row * 512 + (c & 511)]) + CD[(row * 8 + (c & 7)) & 262143];
#elif DBG_STOP == 3
        v = bf1(QN[i]);
#elif DBG_STOP == 4
        v = ((const float*)(ws + WS_SS))[(size_t)12 * MROWS + row * 64 + (c & 63)];
#endif
        out[i] = v;
    }
}
#endif
#ifndef MK_N_LAUNCHES
#define MK_N_LAUNCHES 1
#endif
extern "C" void kernel_launch(void* const* d_in, const int* in_sizes, int n_in, void* d_out, int out_size, void* d_ws, size_t ws_size, hipStream_t stream) {
    static int grid = 0;
    if (grid == 0) {
        if (n_in != 22 || out_size != MROWS * DM || ws_size < WS_END) { fprintf(stderr, "kernel_launch: unexpected shapes (n_in %d out %d ws %zu)\n", n_in, out_size, ws_size); grid = -1; return; }
        int dev = 0, cus = 0, per_cu = 0;
        hipGetDevice(&dev); hipDeviceGetAttribute(&cus, hipDeviceAttributeMultiprocessorCount, dev);
        if (hipFuncSetAttribute((const void*)fwd_kernel, hipFuncAttributeMaxDynamicSharedMemorySize, LDS_BYTES) != hipSuccess) { fprintf(stderr, "kernel_launch: hipFuncSetAttribute failed\n"); grid = -1; return; }
        hipOccupancyMaxActiveBlocksPerMultiprocessor(&per_cu, (const void*)fwd_kernel, 512, LDS_BYTES);
        (void)hipGetLastError();
        if (per_cu < 1) per_cu = 1;
        grid = cus;
    }
    if (grid < 0) return;
    if (hipMemsetAsync(d_ws, 0, 16384, stream) != hipSuccess) { fprintf(stderr, "kernel_launch: memset failed\n"); return; }
    Args a{};
    for (int i = 0; i < 22; ++i) a.in[i] = d_in[i];
    a.out = (float*)d_out; a.ws = (unsigned char*)d_ws;
#if MK_N_LAUNCHES == 1
    a.ph_lo = 0; a.ph_hi = NPHASE; a.coop = 1;
    void* args[] = {&a};
    hipError_t e = hipLaunchCooperativeKernel((const void*)fwd_kernel, dim3(grid), dim3(512), args, LDS_BYTES, stream);
    if (e != hipSuccess) fprintf(stderr, "cooperative launch failed: %s (grid %d)\n", hipGetErrorString(e), grid);
#else
#ifdef DBG_STOP
    const int np = DBG_STOP + 1;
    for (int p = 0; p < np; ++p) { a.ph_lo = p; a.ph_hi = p + 1; a.coop = 0; hipLaunchKernelGGL(fwd_kernel, dim3(grid), dim3(512), LDS_BYTES, stream, a); }
    hipLaunchKernelGGL(dbg_copy, dim3(2048), dim3(256), 0, stream, (unsigned char*)d_ws, (float*)d_out);
#else
    for (int p = 0; p < NPHASE; ++p) { a.ph_lo = p; a.ph_hi = p + 1; a.coop = 0; hipLaunchKernelGGL(fwd_kernel, dim3(grid), dim3(512), LDS_BYTES, stream, a); }
#endif
#endif
}
```

```cpp
#include <hip/hip_runtime.h>
#include <hip/hip_bf16.h>
#include <hip/hip_cooperative_groups.h>
#include <cstdio>
#include <cstdint>
namespace cg = cooperative_groups;
namespace pg8 {
#define PG8_LAS __attribute__((address_space(3)))
typedef unsigned short bf16_t;
typedef short bf16x8 __attribute__((ext_vector_type(8)));
typedef float f32x4 __attribute__((ext_vector_type(4)));
typedef unsigned u32x4 __attribute__((ext_vector_type(4)));
constexpr int BM = 256, BK = 64, HALF = 128, HTB = HALF * BK * 2  , STAGE_BYTES = 8 * HTB, NXCD = 8, WGM = 8;

__host__ __device__ __forceinline__ int lds_byte(int r, int c) { const int st = (r >> 4) * 2 + (c >> 5), rr = r & 15, cc = c & 31, ob = rr * 64 + cc * 2; return st * 1024 + (ob ^ (((ob >> 9) & 1) << 5)); }
__host__ __device__ __forceinline__ void stage_rc(int b, int& R, int& C) { const int st = b / 1024, sb = b % 1024, swz = sb ^ (((sb >> 9) & 1) << 5); R = (st >> 1) * 16 + swz / 64; C = (st & 1) * 32 + (swz % 64) / 2; }
__host__ __device__ __forceinline__ int perm32(int rho) { const int n = rho >> 4, i = rho & 15; return 8 * (i >> 2) + 4 * n + (i & 3); }

struct Unit { int pm, pn; };
struct Gemm { const bf16_t* A; const bf16_t* Bt; int M, N, K, lda; };

struct StaticOrder {
    int nM, nN, nwg, G, c;
    __host__ __device__ void init(int M, int N, int G_, int c_) { nM = M / BM; nN = N / BM; nwg = nM * nN; G = G_; c = c_; }
    __host__ __device__ bool next(int i, Unit& u) const {
        const long L = (long)i * G + c; if (L >= nwg) return false;
        int wgid = (int)L; { const int q = nwg / NXCD, r = nwg % NXCD, xcd = wgid % NXCD, off = wgid / NXCD; wgid = (xcd < r ? xcd * (q + 1) : r * (q + 1) + (xcd - r) * q) + off; }
        const int nig = WGM * nN, gid = wgid / nig, fm = gid * WGM, gsz = (nM - fm) < WGM ? (nM - fm) : WGM;
        u.pm = fm + ((wgid % nig) % gsz); u.pn = (wgid % nig) / gsz; return true;
    }
    __device__ __forceinline__ void a_ready(const Unit&) const {}
    __device__ __forceinline__ void done(const Unit&) const {}
};

__device__ __forceinline__ unsigned cvt_pk_bf16(float lo, float hi) { unsigned r; asm volatile("v_cvt_pk_bf16_f32 %0, %1, %2" : "=v"(r) : "v"(lo), "v"(hi)); return r; }
typedef float f32x2 __attribute__((ext_vector_type(2)));
template <class Epi, class Sched, bool ALIGN_EPI = false, bool SP2 = false>
__device__ __forceinline__ void gemm_phase(PG8_LAS unsigned char* lds, const Gemm g, const Sched& S, const Epi& E) {
    int tid_ = threadIdx.x; asm volatile("" : "+v"(tid_));
    const int tid = tid_, wid = __builtin_amdgcn_readfirstlane(tid >> 6), lane = tid & 63, wr = wid >> 2, wc = wid & 3, fr = lane & 15, fq = lane >> 4;
    const int K = g.K, nt = K / BK;
    unsigned voffA[2], voffB[2];
#pragma unroll
    for (int i = 0; i < 2; ++i) { int R, C; stage_rc(tid * 16 + i * 8192, R, C); const int Rb = Epi::PERM ? ((R & ~31) + perm32(R & 31)) : R;
        voffA[i] = (unsigned)(R * g.lda + C) * 2u; voffB[i] = (unsigned)(Rb * K + C) * 2u; }
    const size_t kstep = (size_t)(BK * 2);
    const size_t hstepA = (size_t)HALF * g.lda * 2, hstepB = (size_t)HALF * K * 2;
    const size_t tstepA = 2 * hstepA, tstepB = 2 * hstepB;
    const unsigned ldsw = (unsigned)wid * 1024u;
    const int aoff = lds_byte(wr * 64 + fr, fq * 8), boff = lds_byte(wc * 32 + fr, fq * 8);
#define PG8_SA(b, h) (((b) * 2 + (h)) * HTB)
#define PG8_SB(b, h) ((4 + (b) * 2 + (h)) * HTB)
#define PG8_STAGE(bufoff, gbase, voff) do { _Pragma("unroll") for (int _i = 0; _i < 2; ++_i) \
        __builtin_amdgcn_global_load_lds((const unsigned*)((const char*)(gbase) + (voff)[_i]), (PG8_LAS unsigned*)(lds + (bufoff) + ldsw + _i * 8192), 16, 0, 0); } while (0)
#define PG8_LDA(dst, b, h) do { _Pragma("unroll") for (int m = 0; m < 4; ++m) _Pragma("unroll") for (int k = 0; k < 2; ++k) dst[m][k] = *(const PG8_LAS bf16x8*)(lds + PG8_SA(b, h) + aoff + m * 2048 + k * 1024); } while (0)
#define PG8_LDB(dst, b, h) do { _Pragma("unroll") for (int n = 0; n < 2; ++n) _Pragma("unroll") for (int k = 0; k < 2; ++k) dst[n][k] = *(const PG8_LAS bf16x8*)(lds + PG8_SB(b, h) + boff + n * 2048 + k * 1024); } while (0)
#define PG8_MMA(ai, bj, At, Bt) do { __builtin_amdgcn_s_setprio(1); _Pragma("unroll") for (int m = 0; m < 4; ++m) _Pragma("unroll") for (int n = 0; n < 2; ++n) _Pragma("unroll") for (int k = 0; k < 2; ++k) \
        acc[ai][bj][m][n] = __builtin_amdgcn_mfma_f32_16x16x32_bf16(Bt[n][k], At[m][k], acc[ai][bj][m][n], 0, 0, 0); __builtin_amdgcn_s_setprio(0); } while (0)
#define PG8_WAIT_V(n) asm volatile("s_waitcnt vmcnt(" #n ")" ::: "memory")
#define PG8_WAIT_L(n) asm volatile("s_waitcnt lgkmcnt(" #n ")" ::: "memory")
#define PG8_BAR __builtin_amdgcn_s_barrier()
#define PG8_SCHED __builtin_amdgcn_sched_barrier(0)
    Unit cur, nxt; int ui = 0;
    if (!S.next(0, cur)) return;
    f32x4 acc[2][2][4][2];
#pragma unroll
    for (int a = 0; a < 2; ++a)
#pragma unroll
        for (int b = 0; b < 2; ++b)
#pragma unroll
            for (int m = 0; m < 4; ++m)
#pragma unroll
                for (int n = 0; n < 2; ++n) acc[a][b][m][n] = (f32x4){0.f, 0.f, 0.f, 0.f};
    bf16x8 At[4][2], B0[2][2], B1[2][2];
    const char* cA = (const char*)g.A + (size_t)cur.pm * tstepA; const char* cB = (const char*)g.Bt + (size_t)cur.pn * tstepB;
    S.a_ready(cur);
    if constexpr (SP2) {
        PG8_STAGE(PG8_SB(0, 0), cB, voffB); PG8_STAGE(PG8_SB(0, 1), cB + hstepB, voffB); PG8_STAGE(PG8_SA(0, 0), cA, voffA); PG8_STAGE(PG8_SA(0, 1), cA + hstepA, voffA);
        if (wr == 1) PG8_BAR;
        PG8_WAIT_V(2); PG8_BAR;
        PG8_STAGE(PG8_SB(1, 0), cB + kstep, voffB); PG8_STAGE(PG8_SA(1, 0), cA + kstep, voffA); PG8_STAGE(PG8_SB(1, 1), cB + hstepB + kstep, voffB);
        PG8_WAIT_V(6); PG8_BAR;
    } else {
        PG8_STAGE(PG8_SB(0, 0), cB, voffB); PG8_STAGE(PG8_SA(0, 0), cA, voffA); PG8_STAGE(PG8_SB(0, 1), cB + hstepB, voffB); PG8_STAGE(PG8_SA(0, 1), cA + hstepA, voffA);
        if (wr == 1) PG8_BAR;
        PG8_WAIT_V(4); PG8_BAR;
        PG8_STAGE(PG8_SB(1, 0), cB + kstep, voffB); PG8_STAGE(PG8_SA(1, 0), cA + kstep, voffA); PG8_STAGE(PG8_SB(1, 1), cB + hstepB + kstep, voffB);
        PG8_WAIT_V(6); PG8_BAR;
    }
    for (;;) {
        const bool has_next = S.next(ui + 1, nxt);
        const char* nA = has_next ? (const char*)g.A + (size_t)nxt.pm * tstepA : cA; const char* nB = has_next ? (const char*)g.Bt + (size_t)nxt.pn * tstepB : cB;
        for (int t = 0; t < nt; t += 2) {
            const bool last = (t == nt - 2);
            const char* a1 = cA + (size_t)(t + 1) * kstep;
            const char* a2 = last ? nA : cA + (size_t)(t + 2) * kstep; const char* b2 = last ? nB : cB + (size_t)(t + 2) * kstep;
            const char* a3 = a2 + kstep; const char* b3 = b2 + kstep;
            if (last && has_next) S.a_ready(nxt);
            if constexpr (SP2) {
            PG8_LDB(B0, 0, 0); PG8_LDB(B1, 0, 1); PG8_SCHED; PG8_LDA(At, 0, 0); PG8_STAGE(PG8_SA(1, 1), a1 + hstepA, voffA);
            PG8_WAIT_V(8); PG8_WAIT_L(0); PG8_BAR; PG8_MMA(0, 0, At, B0); PG8_MMA(0, 1, At, B1); PG8_BAR; PG8_SCHED;
            PG8_LDA(At, 0, 1); PG8_STAGE(PG8_SB(0, 0), b2, voffB); PG8_STAGE(PG8_SB(0, 1), b2 + hstepB, voffB); PG8_STAGE(PG8_SA(0, 0), a2, voffA);
            PG8_WAIT_V(8); PG8_WAIT_L(0); PG8_BAR; PG8_MMA(1, 0, At, B0); PG8_MMA(1, 1, At, B1); PG8_BAR; PG8_SCHED;
            PG8_LDB(B0, 1, 0); PG8_LDB(B1, 1, 1); PG8_SCHED; PG8_LDA(At, 1, 0); PG8_STAGE(PG8_SA(0, 1), a2 + hstepA, voffA);
            PG8_WAIT_V(8); PG8_WAIT_L(0); PG8_BAR; PG8_MMA(0, 0, At, B0); PG8_MMA(0, 1, At, B1); PG8_BAR; PG8_SCHED;
            PG8_LDA(At, 1, 1); PG8_STAGE(PG8_SB(1, 0), b3, voffB); PG8_STAGE(PG8_SB(1, 1), b3 + hstepB, voffB); PG8_STAGE(PG8_SA(1, 0), a3, voffA);
            PG8_WAIT_V(8); PG8_WAIT_L(0); PG8_BAR; PG8_MMA(1, 0, At, B0); PG8_MMA(1, 1, At, B1); PG8_BAR; PG8_SCHED;
            } else {
            PG8_LDB(B0, 0, 0); PG8_SCHED; PG8_LDA(At, 0, 0); PG8_STAGE(PG8_SA(1, 1), a1 + hstepA, voffA);
            PG8_WAIT_L(8); PG8_BAR; PG8_WAIT_L(0); PG8_MMA(0, 0, At, B0); PG8_BAR; PG8_SCHED;
            PG8_LDB(B1, 0, 1); PG8_STAGE(PG8_SB(0, 0), b2, voffB);
            PG8_BAR; PG8_WAIT_L(0); PG8_MMA(0, 1, At, B1); PG8_BAR;
            PG8_LDA(At, 0, 1); PG8_STAGE(PG8_SA(0, 0), a2, voffA);
            PG8_BAR; PG8_WAIT_L(0); PG8_MMA(1, 0, At, B0); PG8_BAR; PG8_SCHED;
            PG8_STAGE(PG8_SB(0, 1), b2 + hstepB, voffB);
            PG8_WAIT_V(6); PG8_BAR; PG8_MMA(1, 1, At, B1); PG8_BAR;
            PG8_LDB(B0, 1, 0); PG8_SCHED; PG8_LDA(At, 1, 0); PG8_STAGE(PG8_SA(0, 1), a2 + hstepA, voffA);
            PG8_WAIT_L(8); PG8_BAR; PG8_WAIT_L(0); PG8_MMA(0, 0, At, B0); PG8_BAR; PG8_SCHED;
            PG8_LDB(B1, 1, 1); PG8_STAGE(PG8_SB(1, 0), b3, voffB);
            PG8_BAR; PG8_WAIT_L(0); PG8_MMA(0, 1, At, B1); PG8_BAR;
            PG8_LDA(At, 1, 1); PG8_STAGE(PG8_SA(1, 0), a3, voffA);
            PG8_BAR; PG8_WAIT_L(0); PG8_MMA(1, 0, At, B0); PG8_BAR; PG8_SCHED;
            PG8_STAGE(PG8_SB(1, 1), b3 + hstepB, voffB);
            PG8_WAIT_V(6); PG8_BAR; PG8_MMA(1, 1, At, B1); PG8_BAR;
            }
        }
        if constexpr (ALIGN_EPI) { if (wr == 0) PG8_BAR; }
        if constexpr (!Epi::AFTER_DRAIN) { E(acc, cur, wr, wc, fr, fq); S.done(cur); }
        if (!has_next) break;
#pragma unroll
        for (int a = 0; a < 2; ++a)
#pragma unroll
            for (int b = 0; b < 2; ++b)
#pragma unroll
                for (int m = 0; m < 4; ++m)
#pragma unroll
                    for (int n = 0; n < 2; ++n) acc[a][b][m][n] = (f32x4){0.f, 0.f, 0.f, 0.f};
        cur = nxt; cA = nA; cB = nB; ++ui;
        if constexpr (ALIGN_EPI) { if (wr == 1) PG8_BAR; }
    }
    PG8_WAIT_V(0);
    if constexpr (!ALIGN_EPI) { if (wr == 0) PG8_BAR; }
    PG8_BAR;
    if constexpr (Epi::AFTER_DRAIN) { E.fused(acc, cur, wr, wc, fr, fq, lds, wid, lane); S.done(cur); }
#undef PG8_SA
#undef PG8_SB
#undef PG8_STAGE
#undef PG8_LDA
#undef PG8_LDB
#undef PG8_MMA
#undef PG8_WAIT_V
#undef PG8_WAIT_L
#undef PG8_BAR
#undef PG8_SCHED
}
}

#define LAS __attribute__((address_space(3)))
using pg8::bf16_t; using pg8::f32x4; using pg8::u32x4; using pg8::bf16x8; using pg8::Unit; using pg8::BM; using pg8::HALF;
typedef unsigned u32x2 __attribute__((ext_vector_type(2)));

constexpr int MROWS = 32768, DM = 1024, SEQ = 8192, NBATCH = 4, DFF = 2816;
constexpr int NCHUNK = MROWS / 64;
constexpr float EPS = 1e-6f;
constexpr float QSCALE = 0.07216878364870322f * 1.4426950408889634f;
constexpr int N1 = 3840, NGATE = 2048, NUQ = 1536, NUKV = 2048, NGU = 5632;
constexpr size_t MiB = 1u << 20;
constexpr size_t WS_SS = 488 * MiB;
constexpr size_t WS_CD = 3 * MiB;
constexpr size_t WS_COS = 4 * MiB, WS_SIN = 8 * MiB;
constexpr size_t WS_WB = 12 * MiB;
constexpr size_t WS_H = 52 * MiB;
constexpr size_t WS_QG = 116 * MiB, WS_KG = 148 * MiB;
constexpr size_t WS_V = 180 * MiB;
constexpr size_t WS_G = 244 * MiB;
constexpr size_t WS_MQ = 308 * MiB, WS_QR = 372 * MiB;
constexpr size_t WS_KDT = 404 * MiB;
constexpr size_t WS_MISC = 436 * MiB;
constexpr size_t WS_CKV = 468 * MiB;
constexpr size_t WS_KPE = 484 * MiB;
constexpr size_t WS_END = 504 * MiB;
constexpr size_t WO_W1 = 0, WO_GATE = WO_W1 + (size_t)N1 * 1024, WO_UQ = WO_GATE + (size_t)NGATE * 1024, WO_UKV = WO_UQ + (size_t)NUQ * 512,
                 WO_OGLA = WO_UKV + (size_t)NUKV * 256, WO_OMLA = WO_OGLA + 1024 * 1024, WO_OUT = WO_OMLA + 1024 * 1024, WO_GU = WO_OUT + 1024 * 1024,
                 WO_DOWN = WO_GU + (size_t)NGU * 1024, WO_END = WO_DOWN + (size_t)1024 * DFF;
static_assert(WO_END * 2 <= 40 * MiB, "weights fit");

typedef float f32x2_t __attribute__((ext_vector_type(2))); typedef __bf16 bf16x2_t __attribute__((ext_vector_type(2)));
__device__ __forceinline__ unsigned pk2(float lo, float hi) { f32x2_t v = {lo, hi}; bf16x2_t b = __builtin_convertvector(v, bf16x2_t); return __builtin_bit_cast(unsigned, b); }
__device__ __forceinline__ u32x4 pack8(const f32x4 a, const f32x4 b) { u32x4 w; w.x = pk2(a[0], a[1]); w.y = pk2(a[2], a[3]); w.z = pk2(b[0], b[1]); w.w = pk2(b[2], b[3]); return w; }
__device__ __forceinline__ float bf_lo(unsigned w) { return __uint_as_float(w << 16); }
__device__ __forceinline__ float bf_hi(unsigned w) { return __uint_as_float(w & 0xffff0000u); }
__device__ __forceinline__ float bf1(bf16_t v) { return __uint_as_float(((unsigned)v) << 16); }
__device__ __forceinline__ float sigm(float x) { return __builtin_amdgcn_rcpf(1.f + __builtin_amdgcn_exp2f(x * -1.4426950408889634f)); }
__device__ __forceinline__ float wave_sum(float v) {
#pragma unroll
    for (int o = 1; o < 64; o <<= 1) v += __shfl_xor(v, o);
    return v;
}
__device__ __forceinline__ float dot4(const f32x4 a) { return (a[0] * a[0] + a[1] * a[1]) + (a[2] * a[2] + a[3] * a[3]); }

typedef f32x4 acc_t[2][2][4][2];

struct EpiG1 {
    static constexpr bool PERM = true, AFTER_DRAIN = false;
    bf16_t *Qg, *Kg, *V, *G, *CKV, *MISC; float *SSQ, *SSKV;
    __device__ __forceinline__ void operator()(const acc_t& acc, const Unit& u, int wr, int wc, int fr, int fq) const {
        const int pn = u.pn; bf16_t* base; int ld, c0;
        if (pn < 2) { base = Qg; ld = 512; c0 = pn * 256; }
        else if (pn < 4) { base = Kg; ld = 512; c0 = (pn - 2) * 256; }
        else if (pn < 8) { base = V; ld = 1024; c0 = (pn - 4) * 256; }
        else if (pn < 12) { base = G; ld = 1024; c0 = (pn - 8) * 256; }
        else if (pn == 12) { base = CKV; ld = 256; c0 = 0; }
        else { base = MISC; ld = 512; c0 = (pn - 13) * 256; }
        float* ssp = (pn == 12) ? (SSKV + wc) : ((pn >= 13) ? (SSQ + (pn - 13) * 4 + wc) : nullptr); const int sst = (pn == 12) ? 4 : 8;
        const bool both = (pn != 14);
        const int row0 = u.pm * BM + wr * 64 + fr, tc = wc * 32 + 8 * fq;
#pragma unroll
        for (int ai = 0; ai < 2; ++ai)
#pragma unroll
            for (int m = 0; m < 4; ++m) {
                const int row = row0 + ai * HALF + m * 16; bf16_t* rowp = base + (size_t)row * ld + c0 + tc; bf16_t* rowp1 = rowp + HALF;
                if (pn < 2) {
                    const int t = row & 63, ck = row >> 6;
#pragma unroll
                    for (int bj = 0; bj < 2; ++bj) { const int c = c0 + tc + bj * HALF, hh = c >> 7, j8 = (c & 127) >> 3, L = ((((t >> 4) * 4 + (j8 >> 2)) * 4 + (j8 & 3)) * 16 + (t & 15)) * 8;
                        bf16_t* p = Qg + (size_t)(ck * 64 + (L >> 7)) * 512 + hh * 128 + (L & 127); if (bj == 0) rowp = p; else rowp1 = p; }
                } else if (pn >= 4 && pn < 8) {
                    const int b_ = row >> 13, t = row & (SEQ - 1);
#pragma unroll
                    for (int bj = 0; bj < 2; ++bj) { const int c = c0 + tc + bj * HALF, hh = c >> 8, dvv = c & 255;
                        bf16_t* p = V + ((size_t)(((b_ * 4 + hh) * 16 + (dvv >> 4))) * SEQ + t) * 16 + (dvv & 8); if (bj == 0) rowp = p; else rowp1 = p; }
                }
                *(u32x4*)(rowp) = pack8(acc[ai][0][m][0], acc[ai][0][m][1]);
                *(u32x4*)(rowp1) = pack8(acc[ai][1][m][0], acc[ai][1][m][1]);
                if (ssp) {
                    float s = dot4(acc[ai][0][m][0]) + dot4(acc[ai][0][m][1]);
                    if (both) s += dot4(acc[ai][1][m][0]) + dot4(acc[ai][1][m][1]);
                    s += __shfl_xor(s, 16); s += __shfl_xor(s, 32);
                    if (fq == 0) ssp[(size_t)row * sst] = s;
                }
            }
    }
};
struct EpiQ {
    static constexpr bool PERM = true, AFTER_DRAIN = false;
    bf16_t *QN, *QR; const float* SSQ;
    __device__ __forceinline__ void operator()(const acc_t& acc, const Unit& u, int wr, int wc, int fr, int fq) const {
        const int pn = u.pn, row0 = u.pm * BM + wr * 64 + fr; bf16_t* base = (pn < 4) ? QN : QR; const int sh = (pn < 4) ? 10 : 9; const int c0 = (pn & 3) * 256 + wc * 32 + 8 * fq;
#pragma unroll
        for (int ai = 0; ai < 2; ++ai)
#pragma unroll
            for (int m = 0; m < 4; ++m) {
                const int row = row0 + ai * HALF + m * 16; const f32x4 q0 = *(const f32x4*)(SSQ + (size_t)row * 8), q1 = *(const f32x4*)(SSQ + (size_t)row * 8 + 4);
                const float rs = rsqrtf((((q0[0] + q0[1]) + (q0[2] + q0[3])) + ((q1[0] + q1[1]) + (q1[2] + q1[3]))) * (1.f / 384.f) + EPS) * QSCALE;
                bf16_t* rowp = base + ((size_t)row << sh) + c0;
                *(u32x4*)(rowp) = pack8(acc[ai][0][m][0] * rs, acc[ai][0][m][1] * rs);
                *(u32x4*)(rowp + HALF) = pack8(acc[ai][1][m][0] * rs, acc[ai][1][m][1] * rs);
                asm volatile("" ::: "memory");
            }
    }
};
struct EpiKV {
    static constexpr bool PERM = true, AFTER_DRAIN = false;
    bf16_t *KN, *VV; const float* SSKV;
    __device__ __forceinline__ void operator()(const acc_t& acc, const Unit& u, int wr, int wc, int fr, int fq) const {
        const int pn = u.pn, row0 = u.pm * BM + wr * 64 + fr; bf16_t* base = (pn < 4) ? KN : VV; const int c0 = (pn & 3) * 256 + wc * 32 + 8 * fq;
#pragma unroll
        for (int ai = 0; ai < 2; ++ai)
#pragma unroll
            for (int m = 0; m < 4; ++m) {
                const int row = row0 + ai * HALF + m * 16; const f32x4 q0 = *(const f32x4*)(SSKV + (size_t)row * 4); const float rs = rsqrtf(((q0[0] + q0[1]) + (q0[2] + q0[3])) * (1.f / 256.f) + EPS);
                bf16_t* rowp = base + (size_t)row * 1024 + c0;
                *(u32x4*)(rowp) = pack8(acc[ai][0][m][0] * rs, acc[ai][0][m][1] * rs);
                *(u32x4*)(rowp + HALF) = pack8(acc[ai][1][m][0] * rs, acc[ai][1][m][1] * rs);
                asm volatile("" ::: "memory");
            }
    }
};
template <bool SS> struct EpiStore {
    static constexpr bool PERM = true, AFTER_DRAIN = false;
    bf16_t* O; int ldc; float* ssp;
    __device__ __forceinline__ void operator()(const acc_t& acc, const Unit& u, int wr, int wc, int fr, int fq) const {
        const int row0 = u.pm * BM + wr * 64 + fr, c0 = u.pn * 256 + wc * 32 + 8 * fq;
#pragma unroll
        for (int ai = 0; ai < 2; ++ai)
#pragma unroll
            for (int m = 0; m < 4; ++m) {
                const int row = row0 + ai * HALF + m * 16; bf16_t* rowp = O + (size_t)row * ldc + c0;
                *(u32x4*)(rowp) = pack8(acc[ai][0][m][0], acc[ai][0][m][1]);
                *(u32x4*)(rowp + HALF) = pack8(acc[ai][1][m][0], acc[ai][1][m][1]);
                if (SS) {
                    float s = dot4(acc[ai][0][m][0]) + dot4(acc[ai][0][m][1]) + dot4(acc[ai][1][m][0]) + dot4(acc[ai][1][m][1]);
                    s += __shfl_xor(s, 16); s += __shfl_xor(s, 32);
                    if (fq == 0) ssp[(size_t)row * 16 + u.pn * 4 + wc] = s;
                }
            }
    }
};
struct EpiMerge {
    static constexpr bool PERM = true, AFTER_DRAIN = false;
    const bf16_t *YA, *YB; const float* bg; bf16_t* MIX;
    __device__ __forceinline__ void operator()(const acc_t& acc, const Unit& u, int wr, int wc, int fr, int fq) const {
        const int row0 = u.pm * BM + wr * 64 + fr, ch = u.pn * 128 + wc * 32 + 8 * fq;
        const f32x4 ba0 = *(const f32x4*)(bg + ch), ba1 = *(const f32x4*)(bg + ch + 4), bb0 = *(const f32x4*)(bg + 1024 + ch), bb1 = *(const f32x4*)(bg + 1024 + ch + 4);
#pragma unroll
        for (int ai = 0; ai < 2; ++ai)
#pragma unroll
            for (int m = 0; m < 4; ++m) {
                const size_t off = (size_t)(row0 + ai * HALF + m * 16) * 1024 + ch;
                const u32x4 ya = *(const u32x4*)(YA + off), yb = *(const u32x4*)(YB + off);
                const f32x4 ga0 = acc[ai][0][m][0] + ba0, ga1 = acc[ai][0][m][1] + ba1, gb0 = acc[ai][1][m][0] + bb0, gb1 = acc[ai][1][m][1] + bb1;
                f32x4 o0, o1;
                o0[0] = sigm(ga0[0]) * bf_lo(ya.x) + sigm(gb0[0]) * bf_lo(yb.x); o0[1] = sigm(ga0[1]) * bf_hi(ya.x) + sigm(gb0[1]) * bf_hi(yb.x);
                o0[2] = sigm(ga0[2]) * bf_lo(ya.y) + sigm(gb0[2]) * bf_lo(yb.y); o0[3] = sigm(ga0[3]) * bf_hi(ya.y) + sigm(gb0[3]) * bf_hi(yb.y);
                o1[0] = sigm(ga1[0]) * bf_lo(ya.z) + sigm(gb1[0]) * bf_lo(yb.z); o1[1] = sigm(ga1[1]) * bf_hi(ya.z) + sigm(gb1[1]) * bf_hi(yb.z);
                o1[2] = sigm(ga1[2]) * bf_lo(ya.w) + sigm(gb1[2]) * bf_lo(yb.w); o1[3] = sigm(ga1[3]) * bf_hi(ya.w) + sigm(gb1[3]) * bf_hi(yb.w);
                *(u32x4*)(MIX + off) = pack8(o0, o1);
                asm volatile("" ::: "memory");
            }
    }
};
struct EpiSwiglu {
    static constexpr bool PERM = true, AFTER_DRAIN = false;
    bf16_t* HID;
    __device__ __forceinline__ void operator()(const acc_t& acc, const Unit& u, int wr, int wc, int fr, int fq) const {
        const int row0 = u.pm * BM + wr * 64 + fr, ch = u.pn * 128 + wc * 32 + 8 * fq;
#pragma unroll
        for (int ai = 0; ai < 2; ++ai)
#pragma unroll
            for (int m = 0; m < 4; ++m) {
                f32x4 o0, o1;
#pragma unroll
                for (int e = 0; e < 4; ++e) { const float g0 = acc[ai][0][m][0][e], g1 = acc[ai][0][m][1][e];
                    o0[e] = g0 * sigm(g0) * acc[ai][1][m][0][e]; o1[e] = g1 * sigm(g1) * acc[ai][1][m][1][e]; }
                *(u32x4*)(HID + (size_t)(row0 + ai * HALF + m * 16) * DFF + ch) = pack8(o0, o1);
            }
    }
};
template <class Epi> __device__ __forceinline__ void run_gemm(LAS unsigned char* lds, const bf16_t* A, int lda, const bf16_t* Bt, int N, int K, const Epi& E) {
    pg8::Gemm g{A, Bt, MROWS, N, K, lda}; pg8::StaticOrder S; S.init(MROWS, N, (int)gridDim.x, (int)blockIdx.x);
    pg8::gemm_phase<Epi, pg8::StaticOrder, true, true>(lds, g, S, E);
}

__device__ __forceinline__ void transpose_item(const float* W, int ldw, int col0, int nvalid, const float* kg, bf16_t* WT, int K, int drow0, int k0, LAS float* scr, int lane) {
#pragma unroll
    for (int i = 0; i < 8; ++i) { const int kk = 8 * i + (lane >> 3), c = 4 * (lane & 7);
        f32x4 v = (c < nvalid) ? *(const f32x4*)(W + (size_t)(k0 + kk) * ldw + col0 + c) : (f32x4){0.f, 0.f, 0.f, 0.f}; if (kg) v = v * kg[k0 + kk];
        LAS float* d = scr + kk * 33 + c; d[0] = v[0]; d[1] = v[1]; d[2] = v[2]; d[3] = v[3]; }
    asm volatile("s_waitcnt lgkmcnt(0)" ::: "memory");
    const int c8 = lane & 7;
#pragma unroll
    for (int j = 0; j < 4; ++j) { const int n = (lane >> 3) + 8 * j; const LAS float* s = scr + (8 * c8) * 33 + n;
        u32x4 o; o.x = pk2(s[0 * 33], s[1 * 33]); o.y = pk2(s[2 * 33], s[3 * 33]); o.z = pk2(s[4 * 33], s[5 * 33]); o.w = pk2(s[6 * 33], s[7 * 33]);
        *(u32x4*)(WT + (size_t)(drow0 + n) * K + k0 + 8 * c8) = o; }
    asm volatile("s_waitcnt lgkmcnt(0)" ::: "memory");
}
struct Ins { const float *x; const int* pos; const float *pre_mix, *w_in, *w_a2, *b_a2, *gla_norm, *w_o_gla, *q_norm, *w_uq, *kv_norm, *w_ukv, *w_o_mla, *w_gate, *b_gate, *w_out,
             *post_mix, *pre_ffn, *w_fg, *w_fu, *w_fd, *post_ffn; };
constexpr int IT_W1 = (N1 / 32) * 16, IT_GATE = (NGATE / 32) * 16, IT_UQ = (NUQ / 32) * 8, IT_UKV = (NUKV / 32) * 4, IT_SQ = 32 * 16, IT_GU = (NGU / 32) * 16, IT_DOWN = 32 * 44;
constexpr int IT_TOTAL = IT_W1 + IT_GATE + IT_UQ + IT_UKV + 3 * IT_SQ + IT_GU + IT_DOWN;
__device__ __forceinline__ void weight_item(int it, const Ins& I, bf16_t* WB, LAS float* scr, int lane) {
    int r = it;
    if (r < IT_W1) { const int g = r / 16, kb = r % 16, n0 = g * 32; int col, nv = 32;
        if (n0 < 3072) col = n0; else if (n0 < 3328) col = 3472 + (n0 - 3072); else if (n0 < 3712) col = 3088 + (n0 - 3328); else if (n0 < 3776) col = 3728 + (n0 - 3712);
        else if (n0 == 3776) { col = 3072; nv = 16; } else { col = 0; nv = 0; }
        transpose_item(I.w_in, 3792, col, nv, nullptr, WB + WO_W1, 1024, n0, kb * 64, scr, lane); return; }
    r -= IT_W1;
    if (r < IT_GATE) { const int g = r / 16, kb = r % 16, n0 = g * 32, t = n0 >> 8, wi = n0 & 255; const int col = (wi < 128) ? (128 * t + wi) : (1024 + 128 * t + wi - 128);
        transpose_item(I.w_gate, 2048, col, 32, nullptr, WB + WO_GATE, 1024, n0, kb * 64, scr, lane); return; }
    r -= IT_GATE;
    if (r < IT_UQ) { const int g = r / 8, kb = r % 8, n0 = g * 32; int col;
        if (n0 < 1024) col = (n0 >> 7) * 192 + (n0 & 127); else { const int q = n0 - 1024; col = (q >> 6) * 192 + 128 + (q & 63); }
        if (kb < 6) transpose_item(I.w_uq, 1536, col, 32, I.q_norm, WB + WO_UQ, 512, n0, kb * 64, scr, lane); else transpose_item(I.w_uq, 1536, col, 0, nullptr, WB + WO_UQ, 512, n0, kb * 64, scr, lane); return; }
    r -= IT_UQ;
    if (r < IT_UKV) { const int g = r / 4, kb = r % 4, n0 = g * 32; const int q = n0 & 1023, col = (q >> 7) * 256 + (n0 >= 1024 ? 128 : 0) + (q & 127);
        transpose_item(I.w_ukv, 2048, col, 32, I.kv_norm, WB + WO_UKV, 256, n0, kb * 64, scr, lane); return; }
    r -= IT_UKV;
    if (r < IT_SQ) { const int g = r / 16, kb = r % 16; transpose_item(I.w_o_gla, 1024, g * 32, 32, nullptr, WB + WO_OGLA, 1024, g * 32, kb * 64, scr, lane); return; }
    r -= IT_SQ;
    if (r < IT_SQ) { const int g = r / 16, kb = r % 16; transpose_item(I.w_o_mla, 1024, g * 32, 32, nullptr, WB + WO_OMLA, 1024, g * 32, kb * 64, scr, lane); return; }
    r -= IT_SQ;
    if (r < IT_SQ) { const int g = r / 16, kb = r % 16; transpose_item(I.w_out, 1024, g * 32, 32, nullptr, WB + WO_OUT, 1024, g * 32, kb * 64, scr, lane); return; }
    r -= IT_SQ;
    if (r < IT_GU) { const int g = r / 16, kb = r % 16, n0 = g * 32, t = n0 >> 8, wi = n0 & 255;
        if (wi < 128) transpose_item(I.w_fg, DFF, 128 * t + wi, 32, nullptr, WB + WO_GU, 1024, n0, kb * 64, scr, lane); else transpose_item(I.w_fu, DFF, 128 * t + wi - 128, 32, nullptr, WB + WO_GU, 1024, n0, kb * 64, scr, lane); return; }
    r -= IT_GU;
    { const int g = r / 44, kb = r % 44; transpose_item(I.w_fd, 1024, g * 32, 32, nullptr, WB + WO_DOWN, DFF, g * 32, kb * 64, scr, lane); }
}
__device__ __forceinline__ void rms_row_to_bf16(const float* xrow, const float* gain, bf16_t* orow, int lane) {
    const f32x4* xr = (const f32x4*)xrow + lane; const f32x4* gr = (const f32x4*)gain + lane;
    f32x4 v[4]; float s = 0.f;
#pragma unroll
    for (int j = 0; j < 4; ++j) { v[j] = xr[64 * j]; s += dot4(v[j]); }
    const float rs = rsqrtf(wave_sum(s) * (1.f / 1024.f) + EPS);
    u32x2* o8 = (u32x2*)orow + lane;
#pragma unroll
    for (int j = 0; j < 4; ++j) { const f32x4 g = gr[64 * j]; u32x2 w; w.x = pk2(v[j][0] * rs * g[0], v[j][1] * rs * g[1]); w.y = pk2(v[j][2] * rs * g[2], v[j][3] * rs * g[3]); o8[64 * j] = w; }
}

__device__ __forceinline__ void gla_prep_item(int item, const bf16_t* Kg, const bf16_t* MISC, const float* w_a2, const float* b_a2, bf16_t* KDT, float* CD, LAS float* part) {
    int tid_ = threadIdx.x; asm volatile("" : "+v"(tid_));
    const int tid = tid_, j = tid & 127, tg = tid >> 7, cgi = item >> 2, h = item & 3, r0 = cgi * 64;
    float w[16];
#pragma unroll
    for (int r = 0; r < 16; ++r) w[r] = w_a2[r * 512 + h * 128 + j];
    const float bias = b_a2[h * 128 + j];
    float bcum[16]; float cum = 0.f;
#pragma unroll
    for (int tt = 0; tt < 16; ++tt) {
        const int row = r0 + tg * 16 + tt;
        const u32x4 ha0 = *(const u32x4*)(MISC + (size_t)row * 512 + 448), ha1 = *(const u32x4*)(MISC + (size_t)row * 512 + 456);
        float z = bias;
        z += bf_lo(ha0.x) * w[0] + bf_hi(ha0.x) * w[1] + bf_lo(ha0.y) * w[2] + bf_hi(ha0.y) * w[3] + bf_lo(ha0.z) * w[4] + bf_hi(ha0.z) * w[5] + bf_lo(ha0.w) * w[6] + bf_hi(ha0.w) * w[7];
        z += bf_lo(ha1.x) * w[8] + bf_hi(ha1.x) * w[9] + bf_lo(ha1.y) * w[10] + bf_hi(ha1.y) * w[11] + bf_lo(ha1.z) * w[12] + bf_hi(ha1.z) * w[13] + bf_lo(ha1.w) * w[14] + bf_hi(ha1.w) * w[15];
        const float ls = fminf(z, 0.f) - __logf(1.f + __expf(-fabsf(z)));
        cum += ls * (1.f / 16.f); bcum[tt] = cum;
    }
    part[tg * 128 + j] = cum;
    __syncthreads();
    const float p0 = part[j], p1 = part[128 + j], p2 = part[256 + j], p3 = part[384 + j];
    const float off = (tg > 0 ? p0 : 0.f) + (tg > 1 ? p1 : 0.f) + (tg > 2 ? p2 : 0.f), total = (p0 + p1) + (p2 + p3);
    unsigned pk[8];
#pragma unroll
    for (int tt = 0; tt < 16; tt += 2) {
        const int row = r0 + tg * 16 + tt;
        const float k0 = bf1(Kg[(size_t)row * 512 + h * 128 + j]) * __expf(total - (bcum[tt] + off));
        const float k1 = bf1(Kg[(size_t)(row + 1) * 512 + h * 128 + j]) * __expf(total - (bcum[tt + 1] + off));
        pk[tt >> 1] = pk2(k0, k1);
    }
    bf16_t* dst = KDT + (size_t)item * 8192 + (((((j >> 4) * 2 + (tg >> 1)) * 4 + (tg & 1) * 2) * 16 + (j & 15)) * 8);
    *(u32x4*)dst = (u32x4){pk[0], pk[1], pk[2], pk[3]}; *(u32x4*)(dst + 128) = (u32x4){pk[4], pk[5], pk[6], pk[7]};
    if (tg == 0) CD[(size_t)item * 128 + j] = __expf(total);
    __syncthreads();
}

struct GlaOps { bf16x8 a0, a1, vp, q0, q1, q2, q3; f32x4 d; };
__device__ __forceinline__ void gla_load(GlaOps& o, int cgi, int h, int s, int w, int fr, int fq, const bf16_t* Qg, const bf16_t* KDT, const float* CD, const bf16_t* Vb) {
    const int r0 = cgi * 64;
    const bf16_t* kdt = KDT + (size_t)(cgi * 4 + h) * 8192 + w * 1024 + fq * 128 + fr * 8;
    o.a0 = *(const bf16x8*)kdt; o.a1 = *(const bf16x8*)(kdt + 512);
    { const int cv = (cgi + 1 < (cgi | 127) ? cgi + 1 : (cgi | 127)), lv = (fq == 0) ? fr : 0;
      o.vp = *(const bf16x8*)(Vb + ((size_t)(((cgi >> 7) * 4 + h) * 16 + s) * SEQ + (size_t)(cv & 127) * 64) * 16 + w * 128 + lv * 8); }
    o.d = *(const f32x4*)(CD + (size_t)(cgi * 4 + h) * 128 + 16 * w + 4 * fq);
    const int fq2 = (w < 4) ? fq : 0, fr2 = (w < 4) ? fr : 0;
    const bf16_t* qp = Qg + (size_t)(r0 + 16 * (w & 3) + fq2) * 512 + h * 128 + fr2 * 8;
    o.q0 = *(const bf16x8*)qp; o.q1 = *(const bf16x8*)(qp + 4 * 512); o.q2 = *(const bf16x8*)(qp + 8 * 512); o.q3 = *(const bf16x8*)(qp + 12 * 512);
}
__device__ __forceinline__ void gla_step(const GlaOps& o, f32x4& S, int c, int w, int fr, int fq, LAS unsigned char* lds) {
    const LAS bf16_t* VL = (const LAS bf16_t*)(lds + 8704) + (c & 1) * 1024;
    typedef short v4i16_t __attribute__((ext_vector_type(4)));
    const LAS bf16_t* vtp = VL + (8 * fq + ((fr >> 2) & 3)) * 16 + (fr & 3) * 4;
    const v4i16_t t0 = __builtin_amdgcn_ds_read_tr16_b64_v4i16((LAS v4i16_t*)(vtp)), t1 = __builtin_amdgcn_ds_read_tr16_b64_v4i16((LAS v4i16_t*)(vtp + 64));
    const v4i16_t t2 = __builtin_amdgcn_ds_read_tr16_b64_v4i16((LAS v4i16_t*)(vtp + 512)), t3 = __builtin_amdgcn_ds_read_tr16_b64_v4i16((LAS v4i16_t*)(vtp + 576));
    const bf16x8 vb0 = {t0[0], t0[1], t0[2], t0[3], t1[0], t1[1], t1[2], t1[3]}, vb1 = {t2[0], t2[1], t2[2], t2[3], t3[0], t3[1], t3[2], t3[3]};
    S = S * o.d;
    S = __builtin_amdgcn_mfma_f32_16x16x32_bf16(o.a0, vb0, S, 0, 0, 0);
    S = __builtin_amdgcn_mfma_f32_16x16x32_bf16(o.a1, vb1, S, 0, 0, 0);
    LAS bf16_t* T = (LAS bf16_t*)lds + (c & 1) * (16 * 136);
    { u32x2 wv; wv.x = pk2(S[0], S[1]); wv.y = pk2(S[2], S[3]); *(LAS u32x2*)(T + fr * 136 + 16 * w + 4 * fq) = wv; }
    if (fq == 0) *(LAS bf16x8*)((LAS bf16_t*)(lds + 8704) + ((c + 1) & 1) * 1024 + w * 128 + fr * 8) = o.vp;
    __syncthreads();
    if (w < 4) {
        const LAS bf16_t* tp = T + fr * 136 + 8 * fq;
        const bf16x8 s0 = *(const LAS bf16x8*)tp, s1 = *(const LAS bf16x8*)(tp + 32), s2 = *(const LAS bf16x8*)(tp + 64), s3 = *(const LAS bf16x8*)(tp + 96);
        f32x4 v = {0.f, 0.f, 0.f, 0.f};
        v = __builtin_amdgcn_mfma_f32_16x16x32_bf16(o.q0, s0, v, 0, 0, 0);
        v = __builtin_amdgcn_mfma_f32_16x16x32_bf16(o.q1, s1, v, 0, 0, 0);
        v = __builtin_amdgcn_mfma_f32_16x16x32_bf16(o.q2, s2, v, 0, 0, 0);
        v = __builtin_amdgcn_mfma_f32_16x16x32_bf16(o.q3, s3, v, 0, 0, 0);
        v = v * 0.08838834764831845f;
        LAS bf16_t* OL = (LAS bf16_t*)(lds + 16384) + (c & 7) * 1024;
#pragma unroll
        for (int r = 0; r < 4; ++r) OL[(16 * w + 4 * fq + r) * 16 + fr] = (bf16_t)(pk2(v[r], 0.f) & 0xffffu);
    }
}
__device__ __forceinline__ void gla_flush(int c, int u, int tid, bf16_t* OGT, float* SSG, LAS unsigned char* lds) {
    __syncthreads();
    const size_t t0 = (size_t)u * SEQ + (size_t)(c - 7) * 64;
    const u32x4 v0 = *(const LAS u32x4*)(lds + 16384 + tid * 32), v1 = *(const LAS u32x4*)(lds + 16384 + tid * 32 + 16);
    *(u32x4*)(OGT + (t0 + tid) * 16) = v0; *(u32x4*)(OGT + (t0 + tid) * 16 + 8) = v1;
}
__device__ __forceinline__ void gla_unit(int u, const bf16_t* Qg, const bf16_t* KDT, const float* CD, const bf16_t* Vb, bf16_t* OGT, float* SSG, LAS unsigned char* lds) {
    int tid_ = threadIdx.x; asm volatile("" : "+v"(tid_));
    const int tid = tid_, lane = tid & 63, w = __builtin_amdgcn_readfirstlane(tid >> 6), fr = lane & 15, fq = lane >> 4;
    const int s = u & 15, h = (u >> 4) & 3, b = u >> 6;
    f32x4 S = {0.f, 0.f, 0.f, 0.f};
    GlaOps A, B, C, D;
    const int c0 = b * 128;
    gla_load(A, c0, h, s, w, fr, fq, Qg, KDT, CD, Vb); gla_load(B, c0 + 1, h, s, w, fr, fq, Qg, KDT, CD, Vb);
    gla_load(C, c0 + 2, h, s, w, fr, fq, Qg, KDT, CD, Vb); gla_load(D, c0 + 3, h, s, w, fr, fq, Qg, KDT, CD, Vb);
    { const int lv = (fq == 0) ? fr : 0;
      const bf16x8 v0 = *(const bf16x8*)(Vb + ((size_t)u * SEQ) * 16 + w * 128 + lv * 8);
      if (fq == 0) *(LAS bf16x8*)((LAS bf16_t*)(lds + 8704) + w * 128 + fr * 8) = v0; }
    __syncthreads();
    for (int c = 0; c < 128; c += 8) {
        const int n0 = c0 + c + 4, n1 = c0 + (c + 8 < 128 ? c + 8 : 124);
        gla_step(A, S, c, w, fr, fq, lds);     gla_load(A, n0, h, s, w, fr, fq, Qg, KDT, CD, Vb);
        gla_step(B, S, c + 1, w, fr, fq, lds); gla_load(B, n0 + 1, h, s, w, fr, fq, Qg, KDT, CD, Vb);
        gla_step(C, S, c + 2, w, fr, fq, lds); gla_load(C, n0 + 2, h, s, w, fr, fq, Qg, KDT, CD, Vb);
        gla_step(D, S, c + 3, w, fr, fq, lds); gla_load(D, n0 + 3, h, s, w, fr, fq, Qg, KDT, CD, Vb);
        gla_step(A, S, c + 4, w, fr, fq, lds); gla_load(A, n1, h, s, w, fr, fq, Qg, KDT, CD, Vb);
        gla_step(B, S, c + 5, w, fr, fq, lds); gla_load(B, n1 + 1, h, s, w, fr, fq, Qg, KDT, CD, Vb);
        gla_step(C, S, c + 6, w, fr, fq, lds); gla_load(C, n1 + 2, h, s, w, fr, fq, Qg, KDT, CD, Vb);
        gla_step(D, S, c + 7, w, fr, fq, lds); gla_load(D, n1 + 3, h, s, w, fr, fq, Qg, KDT, CD, Vb);
        gla_flush(c + 7, u, tid, OGT, SSG, lds);
    }
    __syncthreads();
}

namespace at {
using bf16 = bf16_t;
using s16x4 = __attribute__((ext_vector_type(4))) short;
using f32x16 = __attribute__((ext_vector_type(16))) float;
constexpr int KVBLK = 64;
constexpr float SCALE = 0.07216878364870322f;
constexpr float THR = 8.f;
constexpr int SHM_V = 64 * 128 * 2, SHM_K = 64 * 192 * 2, SHM_ATTN = 2 * SHM_V + 2 * SHM_K + 8 * 64 * 4;
#define KSWZ(row, colB) ((row) * 384 + ((colB) ^ ((((row) >> 1) & 7) << 4)))
#define SBAR() __builtin_amdgcn_sched_barrier(0)
__device__ __forceinline__ int crow(int r, int hi) { return (r & 3) + 8 * (r >> 2) + 4 * hi; }
__device__ __forceinline__ unsigned cvtpk(float lo, float hi) { unsigned r; asm volatile("v_cvt_pk_bf16_f32 %0, %1, %2" : "=v"(r) : "v"(lo), "v"(hi)); return r; }
template <bool FIRST> __device__ __forceinline__ void partialSM(f32x16& p0, f32x16& p1, float& m_ref, float& alpha) {
  constexpr float THRL = THR * 1.4426950408889634f;
  float pmax = p0[0];
#pragma unroll
  for (int r = 1; r < 16; ++r) pmax = fmaxf(pmax, p0[r]);
#pragma unroll
  for (int r = 0; r < 16; ++r) pmax = fmaxf(pmax, p1[r]);
  { auto rr = __builtin_amdgcn_permlane32_swap(__float_as_uint(pmax), __float_as_uint(pmax), false, false);
    pmax = fmaxf(__uint_as_float(rr[0]), __uint_as_float(rr[1])); }
  if (!FIRST && __builtin_expect(__all(pmax <= THRL), 1)) { alpha = 1.f; }
  else { const float d = FIRST ? pmax : fmaxf(pmax, 0.f); m_ref += d; alpha = FIRST ? 0.f : __builtin_amdgcn_exp2f(-d);
#pragma unroll
    for (int r = 0; r < 16; ++r) { p0[r] -= d; p1[r] -= d; } }
#pragma unroll
  for (int r = 0; r < 16; ++r) p0[r] = __builtin_amdgcn_exp2f(p0[r]);
}
__device__ __forceinline__ void finishSM(f32x16& p0, f32x16& p1, float alpha, float& l_reg, bf16x8& pa0, bf16x8& pa1, bf16x8& pa2, bf16x8& pa3) {
#pragma unroll
  for (int r = 0; r < 16; ++r) p1[r] = __builtin_amdgcn_exp2f(p1[r]);
  float ps = 0;
#pragma unroll
  for (int r = 0; r < 16; ++r) ps += p0[r];
#pragma unroll
  for (int r = 0; r < 16; ++r) ps += p1[r];
  { auto rr = __builtin_amdgcn_permlane32_swap(__float_as_uint(ps), __float_as_uint(ps), false, false);
    ps = __uint_as_float(rr[0]) + __uint_as_float(rr[1]); }
  l_reg = l_reg * alpha + ps;
#define PK4(P, BASE, OUT) do { unsigned a0 = cvtpk(P[BASE + 0], P[BASE + 1]), a1 = cvtpk(P[BASE + 2], P[BASE + 3]);   \
    unsigned b0 = cvtpk(P[BASE + 4], P[BASE + 5]), b1 = cvtpk(P[BASE + 6], P[BASE + 7]);                              \
    auto r0 = __builtin_amdgcn_permlane32_swap(a0, b0, false, false); auto r1 = __builtin_amdgcn_permlane32_swap(a1, b1, false, false); \
    u32x4 w = {r0[0], r1[0], r0[1], r1[1]}; OUT = *reinterpret_cast<bf16x8*>(&w); } while (0)
  PK4(p0, 0, pa0); PK4(p0, 8, pa1); PK4(p1, 0, pa2); PK4(p1, 8, pa3);
#undef PK4
}
template <int BUF> __device__ __forceinline__ void qkt(f32x16& p0, f32x16& p1, const unsigned* kb, const bf16x8* qr, const char* Qs, bool visible, float m_ref) {
  typedef __attribute__((address_space(3))) const bf16x8* lds_frag;
  const float init = visible ? -m_ref : -1e30f;
#pragma unroll
  for (int r = 0; r < 16; ++r) { p0[r] = init; p1[r] = init; }
#pragma unroll
  for (int d0 = 0; d0 < 12; ++d0) {
    const bf16x8 qv = (d0 < 6) ? qr[d0 < 6 ? d0 : 0] : *reinterpret_cast<const bf16x8*>(Qs + (d0 - 6) * 1024);
    const bf16x8 b0 = *(lds_frag)(size_t)(kb[d0 & 3] + (unsigned)((d0 >> 2) * 128 + BUF));
    const bf16x8 b1 = *(lds_frag)(size_t)(kb[d0 & 3] + (unsigned)((d0 >> 2) * 128 + BUF + 32 * 384));
    p0 = __builtin_amdgcn_mfma_f32_32x32x16_bf16(b0, qv, p0, 0, 0, 0);
    p1 = __builtin_amdgcn_mfma_f32_32x32x16_bf16(b1, qv, p1, 0, 0, 0); }
}
__device__ __forceinline__ int v_st(int k, int c) { const int kk = (k & ~0xC) | ((k & 4) << 1) | ((k & 8) >> 1); return ((kk >> 3) * 4 + (c >> 5)) * 512 + ((kk & 7) * 32 + (c & 31)) * 2; }
__device__ __forceinline__ int v_rd_base(int lane) { return ((lane & 3) << 3) | (((lane >> 2) & 3) << 6) | (((lane >> 4) & 1) << 5) | (((lane >> 5) & 1) << 8); }
constexpr int v_rd_off(int d0, int ks, int half) { return d0 * 512 + ks * 4096 + half * 2048; }
template <int OFF> __device__ __forceinline__ s16x4 tr_read(int vb) {
  s16x4 r; asm volatile("ds_read_b64_tr_b16 %0, %1 offset:%2" : "=&v"(r) : "v"(vb), "i"(OFF) : "memory"); return r;
}
template <int D0> __device__ __forceinline__ void pv_one(f32x16& od, int vb, bf16x8 pa0, bf16x8 pa1, bf16x8 pa2, bf16x8 pa3) {
  const s16x4 l0 = tr_read<v_rd_off(D0, 0, 0)>(vb), h0 = tr_read<v_rd_off(D0, 0, 1)>(vb), l1 = tr_read<v_rd_off(D0, 1, 0)>(vb), h1 = tr_read<v_rd_off(D0, 1, 1)>(vb);
  const s16x4 l2 = tr_read<v_rd_off(D0, 2, 0)>(vb), h2 = tr_read<v_rd_off(D0, 2, 1)>(vb), l3 = tr_read<v_rd_off(D0, 3, 0)>(vb), h3 = tr_read<v_rd_off(D0, 3, 1)>(vb);
  asm volatile("s_waitcnt lgkmcnt(0)" ::: "memory"); SBAR();
#define PK(L, H) (bf16x8){L[0], L[1], L[2], L[3], H[0], H[1], H[2], H[3]}
  od = __builtin_amdgcn_mfma_f32_32x32x16_bf16(pa0, PK(l0, h0), od, 0, 0, 0);
  od = __builtin_amdgcn_mfma_f32_32x32x16_bf16(pa1, PK(l1, h1), od, 0, 0, 0);
  od = __builtin_amdgcn_mfma_f32_32x32x16_bf16(pa2, PK(l2, h2), od, 0, 0, 0);
  od = __builtin_amdgcn_mfma_f32_32x32x16_bf16(pa3, PK(l3, h3), od, 0, 0, 0);
#undef PK
}
__device__ __forceinline__ void pv_d0(f32x16* o, int vb, bf16x8 pa0, bf16x8 pa1, bf16x8 pa2, bf16x8 pa3) {
  pv_one<0>(o[0], vb, pa0, pa1, pa2, pa3); pv_one<1>(o[1], vb, pa0, pa1, pa2, pa3); pv_one<2>(o[2], vb, pa0, pa1, pa2, pa3); pv_one<3>(o[3], vb, pa0, pa1, pa2, pa3);
}
__device__ __forceinline__ void attn_unit(int b, int h, int qb, const bf16* QN, const bf16* QR, const float* COS, const float* SIN, const bf16* KN, const bf16* KPE, const bf16* VV, bf16* OM, char* lds) {
  int tid_ = threadIdx.x; asm volatile("" : "+v"(tid_));
  const int tid = tid_, wid = __builtin_amdgcn_readfirstlane(tid >> 6), lane = tid & 63, r32 = lane & 31, hi = lane >> 5;
  const long rowbase = (long)b * SEQ + (long)qb * 256;
  const bf16* Kh = KN + (long)b * SEQ * 1024 + h * 128; const bf16* Vh = VV + (long)b * SEQ * 1024 + h * 128; const bf16* Ph = KPE + (long)b * SEQ * 64;
  const int NT = 4 * qb + 4, vis = 4 * qb + (wid >> 1);
  bf16* V_lds = (bf16*)lds; bf16* K_lds = (bf16*)(lds + 2 * SHM_V);
  float* ws = (float*)(lds + 2 * SHM_V + 2 * SHM_K) + wid * 64; float* li_l = ws; float* al_l = ws + 32;
  float m_reg = 0.f, l_reg = 0; f32x16 o[4] = {}; bf16x8 qr[6];
  char* Qs = lds + SHM_ATTN + wid * 6144 + lane * 16;
  const bf16* Qw = QN + (rowbase + wid * 32 + r32) * 1024 + h * 128 + hi * 8; const bf16* Qw2 = QR + (rowbase + wid * 32 + r32) * 512 + h * 64 + hi * 8;
#pragma unroll
  for (int d0 = 0; d0 < 6; ++d0) qr[d0] = *reinterpret_cast<const bf16x8*>(Qw + d0 * 16);
#pragma unroll
  for (int d0 = 6; d0 < 8; ++d0) *reinterpret_cast<bf16x8*>(Qs + (d0 - 6) * 1024) = *reinterpret_cast<const bf16x8*>(Qw + d0 * 16);
#pragma unroll
  for (int g = 0; g < 2; ++g) {
    const u32x4 x1 = *reinterpret_cast<const u32x4*>(Qw2 + g * 16), x2 = *reinterpret_cast<const u32x4*>(Qw2 + 32 + g * 16);
    const float* cp = COS + (rowbase + wid * 32 + r32) * 32 + g * 16 + hi * 8; const float* sp = SIN + (rowbase + wid * 32 + r32) * 32 + g * 16 + hi * 8;
    const f32x4 c0 = *(const f32x4*)cp, c1 = *(const f32x4*)(cp + 4), s0 = *(const f32x4*)sp, s1 = *(const f32x4*)(sp + 4);
    const f32x4 a0 = {bf_lo(x1.x), bf_hi(x1.x), bf_lo(x1.y), bf_hi(x1.y)}, a1 = {bf_lo(x1.z), bf_hi(x1.z), bf_lo(x1.w), bf_hi(x1.w)};
    const f32x4 b0 = {bf_lo(x2.x), bf_hi(x2.x), bf_lo(x2.y), bf_hi(x2.y)}, b1 = {bf_lo(x2.z), bf_hi(x2.z), bf_lo(x2.w), bf_hi(x2.w)};
    *reinterpret_cast<u32x4*>(Qs + (2 + g) * 1024) = pack8(a0 * c0 - b0 * s0, a1 * c1 - b1 * s1);
    *reinterpret_cast<u32x4*>(Qs + (4 + g) * 1024) = pack8(b0 * c0 + a0 * s0, b1 * c1 + a1 * s1);
  }
  const int sr = tid >> 4, sc = (tid & 15) * 8, vst0 = v_st(sr, sc), vst1 = v_st(32 + sr, sc), pr = tid >> 3, pc = (tid & 7) * 8;
  const int vb0 = (int)(uintptr_t)V_lds + v_rd_base(lane);
  bf16x8 vs0, vs1, ks0, ks1, ks2;
#define SLOAD(k0) do { vs0 = *(const bf16x8*)(&Vh[(long)((k0) + sr) * 1024 + sc]); vs1 = *(const bf16x8*)(&Vh[(long)((k0) + 32 + sr) * 1024 + sc]); \
    ks0 = *(const bf16x8*)(&Kh[(long)((k0) + sr) * 1024 + sc]); ks1 = *(const bf16x8*)(&Kh[(long)((k0) + 32 + sr) * 1024 + sc]); \
    ks2 = *(const bf16x8*)(&Ph[(long)((k0) + pr) * 64 + pc]); } while (0)
#define SWRITE(bb) do { *(bf16x8*)((char*)V_lds + (bb) * SHM_V + vst0) = vs0; *(bf16x8*)((char*)V_lds + (bb) * SHM_V + vst1) = vs1; \
    *(bf16x8*)((char*)K_lds + (bb) * SHM_K + KSWZ(sr, sc * 2)) = ks0; *(bf16x8*)((char*)K_lds + (bb) * SHM_K + KSWZ(32 + sr, sc * 2)) = ks1; \
    *(bf16x8*)((char*)K_lds + (bb) * SHM_K + KSWZ(pr, (128 + pc) * 2)) = ks2; } while (0)
#define SWAIT() asm volatile("s_waitcnt vmcnt(0)" ::: "memory")
#define RESC(a) do { if (__any((a) < 1.f)) { if (hi == 0) al_l[r32] = (a); asm volatile("s_waitcnt lgkmcnt(0)" ::: "memory"); \
    _Pragma("unroll") for (int d = 0; d < 4; ++d) _Pragma("unroll") for (int r = 0; r < 16; ++r) o[d][r] *= al_l[crow(r, hi)]; } } while (0)
  f32x16 pA0, pA1, pB0, pB1; float alA, alB; bf16x8 pa0, pa1, pa2, pa3;
  unsigned kb[4];
#pragma unroll
  for (int k = 0; k < 4; ++k) kb[k] = (unsigned)(uintptr_t)K_lds + (unsigned)(r32 * 384 + ((32 * k + 16 * hi) ^ (((r32 >> 1) & 7) << 4)));
  SLOAD(0); SWAIT(); SWRITE(0); __syncthreads();
  qkt<0>(pA0, pA1, kb, qr, Qs, true, 0.f); partialSM<true>(pA0, pA1, m_reg, alA);
  SLOAD(KVBLK);
  SWAIT(); SWRITE(1); __syncthreads();
  for (int j = 1; j + 1 < NT; j += 2) {
    SBAR(); SLOAD((j + 1) * KVBLK); SBAR();
    qkt<SHM_K>(pB0, pB1, kb, qr, Qs, j <= vis, m_reg);
    finishSM(pA0, pA1, alA, l_reg, pa0, pa1, pa2, pa3); SBAR();
    pv_d0(o, vb0, pa0, pa1, pa2, pa3); partialSM<false>(pB0, pB1, m_reg, alB);
    __syncthreads(); SWAIT(); SWRITE(0);
    RESC(alB); __syncthreads();
    SBAR(); SLOAD((j + 2) * KVBLK); SBAR();
    qkt<0>(pA0, pA1, kb, qr, Qs, j + 1 <= vis, m_reg);
    finishSM(pB0, pB1, alB, l_reg, pa0, pa1, pa2, pa3); SBAR();
    pv_d0(o, vb0 + (int)SHM_V, pa0, pa1, pa2, pa3); partialSM<false>(pA0, pA1, m_reg, alA);
    __syncthreads(); SWAIT(); SWRITE(1);
    RESC(alA); __syncthreads();
  }
  SBAR(); qkt<SHM_K>(pB0, pB1, kb, qr, Qs, NT - 1 <= vis, m_reg);
  finishSM(pA0, pA1, alA, l_reg, pa0, pa1, pa2, pa3); SBAR();
  pv_d0(o, vb0, pa0, pa1, pa2, pa3); partialSM<false>(pB0, pB1, m_reg, alB);
  __syncthreads(); RESC(alB);
  finishSM(pB0, pB1, alB, l_reg, pa0, pa1, pa2, pa3); SBAR();
  pv_d0(o, vb0 + (int)SHM_V, pa0, pa1, pa2, pa3);
  if (hi == 0) li_l[r32] = l_reg; asm volatile("s_waitcnt lgkmcnt(0)" ::: "memory");
  float rli[16];
#pragma unroll
  for (int r = 0; r < 16; ++r) rli[r] = __builtin_amdgcn_rcpf(li_l[crow(r, hi)]);
  bf16* Ow = OM + (rowbase + wid * 32) * 1024 + h * 128;
#pragma unroll
  for (int r = 0; r < 16; ++r) { const int orow = crow(r, hi);
#pragma unroll
    for (int d0 = 0; d0 < 4; ++d0) Ow[(long)orow * 1024 + d0 * 32 + r32] = (bf16)(cvtpk(o[d0][r] * rli[r], 0.f) & 0xffffu); }
  __syncthreads();
#undef SLOAD
#undef SWRITE
#undef SWAIT
#undef RESC
}
#undef KSWZ
#undef SBAR
}

#define XB_TMO      128
#define XB_XCNT(j)  (256  + 64 * (j))
#define XB_XSUB(j)  (1280 + 64 * (j))
#define XB_XGEN(j)  (2304 + 64 * (j))
#define XB_TOP      3328
#define XB_TOPGEN   3392
#define XCD_BAR_WORDS 3456
#define XB_SPIN_CAP (1u << 18)

__device__ __forceinline__ unsigned xb_ld(unsigned* p)              { return __hip_atomic_load(p, __ATOMIC_RELAXED, __HIP_MEMORY_SCOPE_AGENT); }
__device__ __forceinline__ unsigned xb_add(unsigned* p, unsigned v) { return __hip_atomic_fetch_add(p, v, __ATOMIC_RELAXED, __HIP_MEMORY_SCOPE_AGENT); }
__device__ __forceinline__ unsigned xb_xcc_id() { return (unsigned)__builtin_amdgcn_s_getreg((3 << 11) | 20) & 0xFu; }
#define XB_SPIN(cond, bar) do { unsigned _sp = 0; while (cond) { __builtin_amdgcn_s_sleep(1); \
    if ((++_sp & 255u) == 0u) { if (xb_ld(&(bar)[XB_TMO])) break; if (_sp > XB_SPIN_CAP) { atomicAdd(&(bar)[XB_TMO], 1u); break; } } } } while (0)

struct XcdBarrier {
    unsigned* bar; unsigned x;
    volatile LAS unsigned* st;
};

__device__ __forceinline__ XcdBarrier xcd_barrier_post(unsigned* bar, volatile LAS unsigned* st) {
    XcdBarrier b; b.bar = bar; b.x = xb_xcc_id(); b.st = st;
    if (threadIdx.x == 0) (void)xb_add(&bar[XB_XCNT(b.x)], 1u);
    return b;
}
__device__ __forceinline__ void xcd_barrier_complete(unsigned* bar, unsigned x, unsigned& nloc, unsigned& nx) {
    const unsigned G = gridDim.x * gridDim.y * gridDim.z;
    unsigned sum, cnt, mine, sp = 0u;
    for (;;) {
        sum = 0u; cnt = 0u; mine = 0u;
#pragma unroll
        for (unsigned j = 0; j < 16; ++j) { const unsigned c = xb_ld(&bar[XB_XCNT(j)]); sum += c; cnt += (c > 0u) ? 1u : 0u; mine = (j == x) ? c : mine; }
        if (sum == G) break;
        __builtin_amdgcn_s_sleep(1);
        if ((++sp & 255u) == 0u) { if (xb_ld(&bar[XB_TMO])) break; if (sp > XB_SPIN_CAP) { atomicAdd(&bar[XB_TMO], 1u); break; } }
    }
    nloc = mine > 0u ? mine : 1u; nx = cnt > 0u ? cnt : 1u;
}

__device__ __forceinline__ void xcd_barrier(const XcdBarrier& b) {
    asm volatile("s_waitcnt vmcnt(0)" ::: "memory");
    __syncthreads();
    if (threadIdx.x == 0) {
        unsigned* bar = b.bar;
        __builtin_amdgcn_s_waitcnt(0);
        unsigned nloc = b.st[0], nx = b.st[1];
        if (nloc == 0u) { xcd_barrier_complete(bar, b.x, nloc, nx); b.st[0] = nloc; b.st[1] = nx; }
        const unsigned old = xb_add(&bar[XB_XSUB(b.x)], 1u);
        const unsigned gen = old / nloc;
        if (old + 1u == (gen + 1u) * nloc) {
            __builtin_amdgcn_fence(__ATOMIC_RELEASE, "agent");
            asm volatile("s_waitcnt vmcnt(0)" ::: "memory");
            const unsigned og = xb_add(&bar[XB_TOP], 1u);
            const unsigned tg = og / nx;
            if (og + 1u == (tg + 1u) * nx) xb_add(&bar[XB_TOPGEN], 1u);
            else XB_SPIN(xb_ld(&bar[XB_TOPGEN]) == tg, bar);
            __builtin_amdgcn_fence(__ATOMIC_ACQUIRE, "agent");
            xb_add(&bar[XB_XGEN(b.x)], 1u);
            asm volatile("s_waitcnt vmcnt(0)" ::: "memory");
        } else {
            XB_SPIN(xb_ld(&bar[XB_XGEN(b.x)]) == gen, bar);
            __builtin_amdgcn_fence(__ATOMIC_ACQUIRE, "agent");
            asm volatile("s_waitcnt vmcnt(0)" ::: "memory");
        }
    }
    __syncthreads();
}

constexpr int NPHASE = 13;
constexpr int IT_TAIL = 3072;
constexpr int LDS_BYTES = 147456;
struct Args { const void* in[22]; float* out; unsigned char* ws; int ph_lo, ph_hi, coop, pad; };

__global__ void __launch_bounds__(512, 2) fwd_kernel(Args a) {
    extern __shared__ __attribute__((aligned(16))) unsigned char lds_raw[];
    LAS unsigned char* lds = (LAS unsigned char*)lds_raw;
    const int wave = __builtin_amdgcn_readfirstlane(threadIdx.x >> 6);
#define PHASE_TID int tid = threadIdx.x; asm volatile("" : "+v"(tid)); const int lane = tid & 63; (void)lane;
    const int G = gridDim.x, bx = blockIdx.x, vcu = (G % 8 == 0) ? (bx % 8) * (G / 8) + bx / 8 : bx;
    const int gw = bx * 8 + wave, NGW = G * 8;
    unsigned char* ws = a.ws;
    Ins I;
    I.x = (const float*)a.in[0]; I.pos = (const int*)a.in[1]; I.pre_mix = (const float*)a.in[2]; I.w_in = (const float*)a.in[3]; I.w_a2 = (const float*)a.in[4]; I.b_a2 = (const float*)a.in[5];
    I.gla_norm = (const float*)a.in[6]; I.w_o_gla = (const float*)a.in[7]; I.q_norm = (const float*)a.in[8]; I.w_uq = (const float*)a.in[9]; I.kv_norm = (const float*)a.in[10];
    I.w_ukv = (const float*)a.in[11]; I.w_o_mla = (const float*)a.in[12]; I.w_gate = (const float*)a.in[13]; I.b_gate = (const float*)a.in[14]; I.w_out = (const float*)a.in[15];
    I.post_mix = (const float*)a.in[16]; I.pre_ffn = (const float*)a.in[17]; I.w_fg = (const float*)a.in[18]; I.w_fu = (const float*)a.in[19]; I.w_fd = (const float*)a.in[20]; I.post_ffn = (const float*)a.in[21];
    float* SS = (float*)(ws + WS_SS); float *SSQ = SS, *SSKV = SS + (size_t)8 * MROWS, *SSG = SS + (size_t)12 * MROWS, *SSY = SS + (size_t)76 * MROWS, *SSF = SS + (size_t)92 * MROWS;
    float* CD = (float*)(ws + WS_CD); float* COS = (float*)(ws + WS_COS); float* SIN = (float*)(ws + WS_SIN);
    bf16_t* WB = (bf16_t*)(ws + WS_WB); bf16_t* H = (bf16_t*)(ws + WS_H); bf16_t* Qg = (bf16_t*)(ws + WS_QG); bf16_t* Kg = (bf16_t*)(ws + WS_KG);
    bf16_t* Vb = (bf16_t*)(ws + WS_V); bf16_t* Gb = (bf16_t*)(ws + WS_G); bf16_t* MQ = (bf16_t*)(ws + WS_MQ); bf16_t* QR = (bf16_t*)(ws + WS_QR); bf16_t* OM = MQ; bf16_t* HID = MQ;
    bf16_t* KDT = (bf16_t*)(ws + WS_KDT); bf16_t* MISC = (bf16_t*)(ws + WS_MISC); bf16_t* CKV = (bf16_t*)(ws + WS_CKV); bf16_t* KPE = (bf16_t*)(ws + WS_KPE);
    bf16_t* KN = (bf16_t*)a.out; bf16_t* VV = KN + (size_t)MROWS * 1024; bf16_t* OGT = KN; bf16_t* YA = KN; bf16_t* YB = VV;
    bf16_t* MIX = Gb; bf16_t* Yo = Vb; bf16_t* Fo = Gb;
    const int lo = a.ph_lo, hi = a.ph_hi;
    volatile LAS unsigned* bst = (volatile LAS unsigned*)(lds + LDS_BYTES - 64);
    XcdBarrier xbar; xbar.bar = (unsigned*)ws; xbar.x = 0; xbar.st = bst;
    if (a.coop) { if (threadIdx.x < 2) bst[threadIdx.x] = 0u; __syncthreads(); xbar = xcd_barrier_post((unsigned*)ws, bst); }
#ifndef PH_MASK
#define PH_MASK 0x1FFF
#endif
#define IN(k) (((PH_MASK >> (k)) & 1) && lo <= (k) && (k) < hi)
#define SEAM(k) do { if (a.coop && IN(k) && IN((k) + 1)) { if (a.pad == 0x5eed) cg::this_grid().sync(); xcd_barrier(xbar); } } while (0)

    if (IN(0)) { PHASE_TID
        LAS float* scr = (LAS float*)(lds + wave * 16384);
        const int p1_units = (MROWS / 256) * (N1 / 256), p1_full = p1_units % G;
        const int it_p0 = (p1_full != 0) ? IT_TOTAL - IT_TAIL : IT_TOTAL;
        for (int it = gw; it < it_p0; it += NGW) weight_item(it, I, WB, scr, lane);
        for (int m = gw; m < MROWS; m += 2 * NGW) {
            const int m2 = m + NGW;
            const f32x4* xa = (const f32x4*)(I.x + (size_t)m * DM) + lane; const f32x4* xb = (const f32x4*)(I.x + (size_t)(m2 < MROWS ? m2 : m) * DM) + lane; const f32x4* gr = (const f32x4*)I.pre_mix + lane;
            f32x4 va[4], vb[4]; float sa = 0.f, sb = 0.f;
#pragma unroll
            for (int j = 0; j < 4; ++j) { va[j] = xa[64 * j]; vb[j] = xb[64 * j]; }
#pragma unroll
            for (int j = 0; j < 4; ++j) { sa += dot4(va[j]); sb += dot4(vb[j]); }
            const float ra = rsqrtf(wave_sum(sa) * (1.f / 1024.f) + EPS), rb = rsqrtf(wave_sum(sb) * (1.f / 1024.f) + EPS);
            u32x2* oa = (u32x2*)(H + (size_t)m * DM) + lane; u32x2* ob = (u32x2*)(H + (size_t)(m2 < MROWS ? m2 : m) * DM) + lane;
#pragma unroll
            for (int j = 0; j < 4; ++j) { const f32x4 g = gr[64 * j]; u32x2 w;
                w.x = pk2(va[j][0] * ra * g[0], va[j][1] * ra * g[1]); w.y = pk2(va[j][2] * ra * g[2], va[j][3] * ra * g[3]); oa[64 * j] = w;
                if (m2 < MROWS) { w.x = pk2(vb[j][0] * rb * g[0], vb[j][1] * rb * g[1]); w.y = pk2(vb[j][2] * rb * g[2], vb[j][3] * rb * g[3]); ob[64 * j] = w; } }
        }
        for (int i = bx * 512 + tid; i < MROWS * 32; i += G * 512) {
            const int row = i >> 5, f = i & 31;
            const float inv = __builtin_amdgcn_exp2f(-(float)f * (13.287712379549449f / 32.f));
            float rev = (float)I.pos[row] * inv * 0.15915494309189535f; rev -= rintf(rev);
            COS[i] = __builtin_amdgcn_cosf(rev); SIN[i] = __builtin_amdgcn_sinf(rev);
        }
    }
    SEAM(0);
    if (IN(1)) { PHASE_TID
        { EpiG1 E{Qg, Kg, Vb, Gb, CKV, MISC, SSQ, SSKV}; run_gemm(lds, H, 1024, WB + WO_W1, N1, 1024, E); }
        const int p1_units = (MROWS / 256) * (N1 / 256), p1_full = p1_units % G;
        if (p1_full != 0 && bx >= p1_full) {
            LAS float* scr = (LAS float*)(lds + wave * 16384); const int nsw = (G - p1_full) * 8, lw = (bx - p1_full) * 8 + wave;
            for (int it = IT_TOTAL - IT_TAIL + lw; it < IT_TOTAL; it += nsw) weight_item(it, I, WB, scr, lane);
        }
    }
    SEAM(1);
    if (IN(2)) { PHASE_TID
        for (int i = bx * 512 + tid; i < MROWS * 32; i += G * 512) {
            const int row = i >> 5, f = i & 31; const float c = COS[i], s = SIN[i];
            const float x1 = bf1(MISC[(size_t)row * 512 + 384 + f]), x2 = bf1(MISC[(size_t)row * 512 + 416 + f]);
            KPE[(size_t)row * 64 + f] = (bf16_t)(pk2(x1 * c - x2 * s, 0.f) & 0xffffu); KPE[(size_t)row * 64 + 32 + f] = (bf16_t)(pk2(x2 * c + x1 * s, 0.f) & 0xffffu);
        }
#ifndef SKIP_PREP
        for (int it = bx; it < NCHUNK * 4; it += G) gla_prep_item(it, Kg, MISC, I.w_a2, I.b_a2, KDT, CD, (LAS float*)lds);
#endif
        { EpiQ E{MQ, QR, SSQ}; run_gemm(lds, MISC, 512, WB + WO_UQ, NUQ, 512, E); }
#ifndef SKIP_KV
        { EpiKV E{KN, VV, SSKV}; run_gemm(lds, CKV, 256, WB + WO_UKV, NUKV, 256, E); }
#endif
    }
    SEAM(2);
    if (IN(3)) {
        for (int idx = vcu; idx < 1024; idx += G) {
            const int v = idx & 255, i = idx >> 8, s = v & 7, bh = v >> 3; const int qb = (i == 0) ? s : (i == 1) ? 15 - s : (i == 2) ? 16 + s : 31 - s;
            at::attn_unit(bh >> 3, bh & 7, qb, MQ, QR, COS, SIN, KN, KPE, VV, OM, (char*)lds_raw);
        }
    }
    SEAM(3);
    if (IN(4)) { for (int u = vcu; u < 256; u += G) gla_unit(u, Qg, KDT, CD, Vb, OGT, SSG, lds); }
    SEAM(4);
    if (IN(5)) { PHASE_TID
        for (int m = gw; m < MROWS; m += NGW) {
            bf16_t* orow = Vb + (size_t)m * 1024 + 16 * lane; const bf16_t* grow = Gb + (size_t)m * 1024 + 16 * lane;
            const bf16_t* irow = OGT + ((size_t)(((m >> 13) * 4 + (lane >> 4)) * 16 + (lane & 15)) * SEQ + (m & (SEQ - 1))) * 16;
            const u32x4 ovA = *(const u32x4*)(irow), ovB = *(const u32x4*)(irow + 8);
            float ssg = ((bf_lo(ovA.x) * bf_lo(ovA.x) + bf_hi(ovA.x) * bf_hi(ovA.x)) + (bf_lo(ovA.y) * bf_lo(ovA.y) + bf_hi(ovA.y) * bf_hi(ovA.y))) + ((bf_lo(ovA.z) * bf_lo(ovA.z) + bf_hi(ovA.z) * bf_hi(ovA.z)) + (bf_lo(ovA.w) * bf_lo(ovA.w) + bf_hi(ovA.w) * bf_hi(ovA.w)));
            ssg += ((bf_lo(ovB.x) * bf_lo(ovB.x) + bf_hi(ovB.x) * bf_hi(ovB.x)) + (bf_lo(ovB.y) * bf_lo(ovB.y) + bf_hi(ovB.y) * bf_hi(ovB.y))) + ((bf_lo(ovB.z) * bf_lo(ovB.z) + bf_hi(ovB.z) * bf_hi(ovB.z)) + (bf_lo(ovB.w) * bf_lo(ovB.w) + bf_hi(ovB.w) * bf_hi(ovB.w)));
            ssg += __shfl_xor(ssg, 1); ssg += __shfl_xor(ssg, 2); ssg += __shfl_xor(ssg, 4); ssg += __shfl_xor(ssg, 8);
            const float rs = rsqrtf(ssg * (1.f / 256.f) + EPS); const float* gn = I.gla_norm + 16 * (lane & 15);
#pragma unroll
            for (int k = 0; k < 2; ++k) {
                const u32x4 ov = *(const u32x4*)(irow + 8 * k), gv = *(const u32x4*)(grow + 8 * k); const f32x4 n0 = *(const f32x4*)(gn + 8 * k), n1 = *(const f32x4*)(gn + 8 * k + 4);
                f32x4 r0, r1; float g;
                g = bf_lo(gv.x); r0[0] = bf_lo(ov.x) * rs * n0[0] * g * sigm(g); g = bf_hi(gv.x); r0[1] = bf_hi(ov.x) * rs * n0[1] * g * sigm(g);
                g = bf_lo(gv.y); r0[2] = bf_lo(ov.y) * rs * n0[2] * g * sigm(g); g = bf_hi(gv.y); r0[3] = bf_hi(ov.y) * rs * n0[3] * g * sigm(g);
                g = bf_lo(gv.z); r1[0] = bf_lo(ov.z) * rs * n1[0] * g * sigm(g); g = bf_hi(gv.z); r1[1] = bf_hi(ov.z) * rs * n1[1] * g * sigm(g);
                g = bf_lo(gv.w); r1[2] = bf_lo(ov.w) * rs * n1[2] * g * sigm(g); g = bf_hi(gv.w); r1[3] = bf_hi(ov.w) * rs * n1[3] * g * sigm(g);
                *(u32x4*)(orow + 8 * k) = pack8(r0, r1);
            }
        }
        { EpiStore<false> E{YB, 1024, nullptr}; run_gemm(lds, OM, 1024, WB + WO_OMLA, 1024, 1024, E); }
    }
    SEAM(5);
    if (IN(6)) { EpiStore<false> E{YA, 1024, nullptr}; run_gemm(lds, Vb, 1024, WB + WO_OGLA, 1024, 1024, E); }
    SEAM(6);
    if (IN(7)) { EpiMerge E{YA, YB, I.b_gate, MIX}; run_gemm(lds, H, 1024, WB + WO_GATE, NGATE, 1024, E); }
    SEAM(7);
    if (IN(8)) { EpiStore<true> E{Yo, 1024, SSY}; run_gemm(lds, MIX, 1024, WB + WO_OUT, 1024, 1024, E); }
    SEAM(8);
    if (IN(9)) { PHASE_TID
        for (int m = gw; m < MROWS; m += NGW) {
            const f32x4* xr = (const f32x4*)(I.x + (size_t)m * DM) + lane; const u32x2* yr = (const u32x2*)(Yo + (size_t)m * DM) + lane;
            const f32x4* g1 = (const f32x4*)I.post_mix + lane; const f32x4* g2 = (const f32x4*)I.pre_ffn + lane;
            float ssm; { const f32x4* sp = (const f32x4*)(SSY + (size_t)m * 16); const f32x4 t0 = sp[0], t1 = sp[1], t2 = sp[2], t3 = sp[3];
                ssm = (((t0[0] + t0[1]) + (t0[2] + t0[3])) + ((t1[0] + t1[1]) + (t1[2] + t1[3]))) + (((t2[0] + t2[1]) + (t2[2] + t2[3])) + ((t3[0] + t3[1]) + (t3[2] + t3[3]))); }
            const float rs = rsqrtf(ssm * (1.f / 1024.f) + EPS);
            f32x4 v[4]; float s = 0.f;
#pragma unroll
            for (int j = 0; j < 4; ++j) { const f32x4 xv = xr[64 * j]; const u32x2 yv = yr[64 * j]; const f32x4 gv = g1[64 * j];
                v[j][0] = xv[0] + bf_lo(yv.x) * rs * gv[0]; v[j][1] = xv[1] + bf_hi(yv.x) * rs * gv[1]; v[j][2] = xv[2] + bf_lo(yv.y) * rs * gv[2]; v[j][3] = xv[3] + bf_hi(yv.y) * rs * gv[3];
                s += dot4(v[j]); }
            const float rs2 = rsqrtf(wave_sum(s) * (1.f / 1024.f) + EPS);
            u32x2* hrow = (u32x2*)(H + (size_t)m * DM) + lane;
#pragma unroll
            for (int j = 0; j < 4; ++j) { const f32x4 gv = g2[64 * j]; u32x2 w; w.x = pk2(v[j][0] * rs2 * gv[0], v[j][1] * rs2 * gv[1]); w.y = pk2(v[j][2] * rs2 * gv[2], v[j][3] * rs2 * gv[3]); hrow[64 * j] = w; }
        }
    }
    SEAM(9);
    if (IN(10)) { EpiSwiglu E{HID}; run_gemm(lds, H, 1024, WB + WO_GU, NGU, 1024, E); }
    SEAM(10);
    if (IN(11)) { EpiStore<true> E{Fo, 1024, SSF}; run_gemm(lds, HID, DFF, WB + WO_DOWN, 1024, DFF, E); }
    SEAM(11);
    if (IN(12)) { PHASE_TID
        for (int m = gw; m < MROWS; m += NGW) {
            f32x4* orow = (f32x4*)(a.out + (size_t)m * DM) + lane; const f32x4* xr = (const f32x4*)(I.x + (size_t)m * DM) + lane;
            const u32x2* yr = (const u32x2*)(Yo + (size_t)m * DM) + lane; const u32x2* fr_ = (const u32x2*)(Fo + (size_t)m * DM) + lane;
            const f32x4* g1 = (const f32x4*)I.post_mix + lane; const f32x4* g2 = (const f32x4*)I.post_ffn + lane;
            float ss1, ss2;
            { const f32x4* sp = (const f32x4*)(SSY + (size_t)m * 16); const f32x4 t0 = sp[0], t1 = sp[1], t2 = sp[2], t3 = sp[3];
              ss1 = (((t0[0] + t0[1]) + (t0[2] + t0[3])) + ((t1[0] + t1[1]) + (t1[2] + t1[3]))) + (((t2[0] + t2[1]) + (t2[2] + t2[3])) + ((t3[0] + t3[1]) + (t3[2] + t3[3]))); }
            { const f32x4* sp = (const f32x4*)(SSF + (size_t)m * 16); const f32x4 t0 = sp[0], t1 = sp[1], t2 = sp[2], t3 = sp[3];
              ss2 = (((t0[0] + t0[1]) + (t0[2] + t0[3])) + ((t1[0] + t1[1]) + (t1[2] + t1[3]))) + (((t2[0] + t2[1]) + (t2[2] + t2[3])) + ((t3[0] + t3[1]) + (t3[2] + t3[3]))); }
            const float rs1 = rsqrtf(ss1 * (1.f / 1024.f) + EPS), rs2 = rsqrtf(ss2 * (1.f / 1024.f) + EPS);
#pragma unroll
            for (int j = 0; j < 4; ++j) { const f32x4 xv = xr[64 * j]; const u32x2 yv = yr[64 * j], fv = fr_[64 * j]; const f32x4 ga = g1[64 * j], gb = g2[64 * j]; f32x4 o;
                o[0] = (xv[0] + bf_lo(yv.x) * rs1 * ga[0]) + bf_lo(fv.x) * rs2 * gb[0]; o[1] = (xv[1] + bf_hi(yv.x) * rs1 * ga[1]) + bf_hi(fv.x) * rs2 * gb[1];
                o[2] = (xv[2] + bf_lo(yv.y) * rs1 * ga[2]) + bf_lo(fv.y) * rs2 * gb[2]; o[3] = (xv[3] + bf_hi(yv.y) * rs1 * ga[3]) + bf_hi(fv.y) * rs2 * gb[3];
                orow[64 * j] = o; }
        }
    }
#undef IN
#undef SEAM
}


#ifdef DBG_STOP
__global__ void dbg_copy(unsigned char* ws, float* out) {
    const bf16_t* Vb = (const bf16_t*)(ws + WS_V); const bf16_t* Gb = (const bf16_t*)(ws + WS_G); const bf16_t* Qg = (const bf16_t*)(ws + WS_QG); const bf16_t* Kg = (const bf16_t*)(ws + WS_KG);
    const bf16_t* MISC = (const bf16_t*)(ws + WS_MISC); const bf16_t* CKV = (const bf16_t*)(ws + WS_CKV); const bf16_t* QN = (const bf16_t*)(ws + WS_MQ); const bf16_t* QR = (const bf16_t*)(ws + WS_QR);
    const bf16_t* KDT = (const bf16_t*)(ws + WS_KDT); const bf16_t* KPE = (const bf16_t*)(ws + WS_KPE); const bf16_t* KN = (const bf16_t*)out; const bf16_t* H = (const bf16_t*)(ws + WS_H);
    const float* CD = (const float*)(ws + WS_CD);
    for (size_t i = (size_t)blockIdx.x * blockDim.x + threadIdx.x; i < (size_t)MROWS * 1024; i += (size_t)gridDim.x * blockDim.x) {
        const size_t row = i >> 10, c = i & 1023; float v = 0.f;
#if DBG_STOP == 1
        v = bf1(Vb[i]) + bf1(Gb[i]) + bf1(Qg[row * 512 + (c & 511)]) + bf1(Kg[row * 512 + (c & 511)]) + bf1(MISC[row * 512 + (c & 511)]) + bf1(CKV[row * 256 + (c & 255)]) + bf1(H[i]);
#elif DBG_STOP == 2
        v = bf1(QN[i]) + bf1(QR[row * 512 + (c & 511)]) + bf1(KPE[row * 64 + (c & 63)]) + bf1(KDT[row * 512 + (c & 511)]) + CD[(row * 8 + (c & 7)) & 262143];
#elif DBG_STOP == 3
        v = bf1(QN[i]);
#elif DBG_STOP == 4
        v = ((const float*)(ws + WS_SS))[(size_t)12 * MROWS + row * 64 + (c & 63)];
#endif
        out[i] = v;
    }
}
#endif
#ifndef MK_N_LAUNCHES
#define MK_N_LAUNCHES 1
#endif
extern "C" void kernel_launch(void* const* d_in, const int* in_sizes, int n_in, void* d_out, int out_size, void* d_ws, size_t ws_size, hipStream_t stream) {
    static int grid = 0;
    if (grid == 0) {
        if (n_in != 22 || out_size != MROWS * DM || ws_size < WS_END) { fprintf(stderr, "kernel_launch: unexpected shapes (n_in %d out %d ws %zu)\n", n_in, out_size, ws_size); grid = -1; return; }
        int dev = 0, cus = 0, per_cu = 0;
        hipGetDevice(&dev); hipDeviceGetAttribute(&cus, hipDeviceAttributeMultiprocessorCount, dev);
        if (hipFuncSetAttribute((const void*)fwd_kernel, hipFuncAttributeMaxDynamicSharedMemorySize, LDS_BYTES) != hipSuccess) { fprintf(stderr, "kernel_launch: hipFuncSetAttribute failed\n"); grid = -1; return; }
        hipOccupancyMaxActiveBlocksPerMultiprocessor(&per_cu, (const void*)fwd_kernel, 512, LDS_BYTES);
        (void)hipGetLastError();
        if (per_cu < 1) per_cu = 1;
        grid = cus;
    }
    if (grid < 0) return;
    if (hipMemsetAsync(d_ws, 0, 16384, stream) != hipSuccess) { fprintf(stderr, "kernel_launch: memset failed\n"); return; }
    Args a{};
    for (int i = 0; i < 22; ++i) a.in[i] = d_in[i];
    a.out = (float*)d_out; a.ws = (unsigned char*)d_ws;
#if MK_N_LAUNCHES == 1
    a.ph_lo = 0; a.ph_hi = NPHASE; a.coop = 1;
    void* args[] = {&a};
    hipError_t e = hipLaunchCooperativeKernel((const void*)fwd_kernel, dim3(grid), dim3(512), args, LDS_BYTES, stream);
    if (e != hipSuccess) fprintf(stderr, "cooperative launch failed: %s (grid %d)\n", hipGetErrorString(e), grid);
#else
#ifdef DBG_STOP
    const int np = DBG_STOP + 1;
    for (int p = 0; p < np; ++p) { a.ph_lo = p; a.ph_hi = p + 1; a.coop = 0; hipLaunchKernelGGL(fwd_kernel, dim3(grid), dim3(512), LDS_BYTES, stream, a); }
    hipLaunchKernelGGL(dbg_copy, dim3(2048), dim3(256), 0, stream, (unsigned char*)d_ws, (float*)d_out);
#else
    for (int p = 0; p < NPHASE; ++p) { a.ph_lo = p; a.ph_hi = p + 1; a.coop = 0; hipLaunchKernelGGL(fwd_kernel, dim3(grid), dim3(512), LDS_BYTES, stream, a); }
#endif
#endif
}
```

```cpp
#include <hip/hip_runtime.h>
#include <hip/hip_bf16.h>
#include <hip/hip_cooperative_groups.h>
#include <cstdio>
#include <cstdint>
namespace cg = cooperative_groups;
namespace pg8 {
#define PG8_LAS __attribute__((address_space(3)))
typedef unsigned short bf16_t;
typedef short bf16x8 __attribute__((ext_vector_type(8)));
typedef float f32x4 __attribute__((ext_vector_type(4)));
typedef unsigned u32x4 __attribute__((ext_vector_type(4)));
constexpr int BM = 256, BK = 64, HALF = 128, HTB = HALF * BK * 2  , STAGE_BYTES = 8 * HTB, NXCD = 8, WGM = 8;

__host__ __device__ __forceinline__ int lds_byte(int r, int c) { const int st = (r >> 4) * 2 + (c >> 5), rr = r & 15, cc = c & 31, ob = rr * 64 + cc * 2; return st * 1024 + (ob ^ (((ob >> 9) & 1) << 5)); }
__host__ __device__ __forceinline__ void stage_rc(int b, int& R, int& C) { const int st = b / 1024, sb = b % 1024, swz = sb ^ (((sb >> 9) & 1) << 5); R = (st >> 1) * 16 + swz / 64; C = (st & 1) * 32 + (swz % 64) / 2; }
__host__ __device__ __forceinline__ int perm32(int rho) { const int n = rho >> 4, i = rho & 15; return 8 * (i >> 2) + 4 * n + (i & 3); }

struct Unit { int pm, pn; };
struct Gemm { const bf16_t* A; const bf16_t* Bt; int M, N, K, lda; };

struct StaticOrder {
    int nM, nN, nwg, G, c;
    __host__ __device__ void init(int M, int N, int G_, int c_) { nM = M / BM; nN = N / BM; nwg = nM * nN; G = G_; c = c_; }
    __host__ __device__ bool next(int i, Unit& u) const {
        const long L = (long)i * G + c; if (L >= nwg) return false;
        int wgid = (int)L; { const int q = nwg / NXCD, r = nwg % NXCD, xcd = wgid % NXCD, off = wgid / NXCD; wgid = (xcd < r ? xcd * (q + 1) : r * (q + 1) + (xcd - r) * q) + off; }
        const int nig = WGM * nN, gid = wgid / nig, fm = gid * WGM, gsz = (nM - fm) < WGM ? (nM - fm) : WGM;
        u.pm = fm + ((wgid % nig) % gsz); u.pn = (wgid % nig) / gsz; return true;
    }
    __device__ __forceinline__ void a_ready(const Unit&) const {}
    __device__ __forceinline__ void done(const Unit&) const {}
};

__device__ __forceinline__ unsigned cvt_pk_bf16(float lo, float hi) { unsigned r; asm volatile("v_cvt_pk_bf16_f32 %0, %1, %2" : "=v"(r) : "v"(lo), "v"(hi)); return r; }
typedef float f32x2 __attribute__((ext_vector_type(2)));
template <class Epi, class Sched, bool ALIGN_EPI = false, bool SP2 = false>
__device__ __forceinline__ void gemm_phase(PG8_LAS unsigned char* lds, const Gemm g, const Sched& S, const Epi& E) {
    int tid_ = threadIdx.x; asm volatile("" : "+v"(tid_));
    const int tid = tid_, wid = __builtin_amdgcn_readfirstlane(tid >> 6), lane = tid & 63, wr = wid >> 2, wc = wid & 3, fr = lane & 15, fq = lane >> 4;
    const int K = g.K, nt = K / BK;
    unsigned voffA[2], voffB[2];
#pragma unroll
    for (int i = 0; i < 2; ++i) { int R, C; stage_rc(tid * 16 + i * 8192, R, C); const int Rb = Epi::PERM ? ((R & ~31) + perm32(R & 31)) : R;
        voffA[i] = (unsigned)(R * g.lda + C) * 2u; voffB[i] = (unsigned)(Rb * K + C) * 2u; }
    const size_t kstep = (size_t)(BK * 2);
    const size_t hstepA = (size_t)HALF * g.lda * 2, hstepB = (size_t)HALF * K * 2;
    const size_t tstepA = 2 * hstepA, tstepB = 2 * hstepB;
    const unsigned ldsw = (unsigned)wid * 1024u;
    const int aoff = lds_byte(wr * 64 + fr, fq * 8), boff = lds_byte(wc * 32 + fr, fq * 8);
#define PG8_SA(b, h) (((b) * 2 + (h)) * HTB)
#define PG8_SB(b, h) ((4 + (b) * 2 + (h)) * HTB)
#define PG8_STAGE(bufoff, gbase, voff) do { _Pragma("unroll") for (int _i = 0; _i < 2; ++_i) \
        __builtin_amdgcn_global_load_lds((const unsigned*)((const char*)(gbase) + (voff)[_i]), (PG8_LAS unsigned*)(lds + (bufoff) + ldsw + _i * 8192), 16, 0, 0); } while (0)
#define PG8_LDA(dst, b, h) do { _Pragma("unroll") for (int m = 0; m < 4; ++m) _Pragma("unroll") for (int k = 0; k < 2; ++k) dst[m][k] = *(const PG8_LAS bf16x8*)(lds + PG8_SA(b, h) + aoff + m * 2048 + k * 1024); } while (0)
#define PG8_LDB(dst, b, h) do { _Pragma("unroll") for (int n = 0; n < 2; ++n) _Pragma("unroll") for (int k = 0; k < 2; ++k) dst[n][k] = *(const PG8_LAS bf16x8*)(lds + PG8_SB(b, h) + boff + n * 2048 + k * 1024); } while (0)
#define PG8_MMA(ai, bj, At, Bt) do { __builtin_amdgcn_s_setprio(1); _Pragma("unroll") for (int m = 0; m < 4; ++m) _Pragma("unroll") for (int n = 0; n < 2; ++n) _Pragma("unroll") for (int k = 0; k < 2; ++k) \
        acc[ai][bj][m][n] = __builtin_amdgcn_mfma_f32_16x16x32_bf16(Bt[n][k], At[m][k], acc[ai][bj][m][n], 0, 0, 0); __builtin_amdgcn_s_setprio(0); } while (0)
#define PG8_WAIT_V(n) asm volatile("s_waitcnt vmcnt(" #n ")" ::: "memory")
#define PG8_WAIT_L(n) asm volatile("s_waitcnt lgkmcnt(" #n ")" ::: "memory")
#define PG8_BAR __builtin_amdgcn_s_barrier()
#define PG8_SCHED __builtin_amdgcn_sched_barrier(0)
    Unit cur, nxt; int ui = 0;
    if (!S.next(0, cur)) return;
    f32x4 acc[2][2][4][2];
#pragma unroll
    for (int a = 0; a < 2; ++a)
#pragma unroll
        for (int b = 0; b < 2; ++b)
#pragma unroll
            for (int m = 0; m < 4; ++m)
#pragma unroll
                for (int n = 0; n < 2; ++n) acc[a][b][m][n] = (f32x4){0.f, 0.f, 0.f, 0.f};
    bf16x8 At[4][2], B0[2][2], B1[2][2];
    const char* cA = (const char*)g.A + (size_t)cur.pm * tstepA; const char* cB = (const char*)g.Bt + (size_t)cur.pn * tstepB;
    S.a_ready(cur);
    if constexpr (SP2) {
        PG8_STAGE(PG8_SB(0, 0), cB, voffB); PG8_STAGE(PG8_SB(0, 1), cB + hstepB, voffB); PG8_STAGE(PG8_SA(0, 0), cA, voffA); PG8_STAGE(PG8_SA(0, 1), cA + hstepA, voffA);
        if (wr == 1) PG8_BAR;
        PG8_WAIT_V(2); PG8_BAR;
        PG8_STAGE(PG8_SB(1, 0), cB + kstep, voffB); PG8_STAGE(PG8_SA(1, 0), cA + kstep, voffA); PG8_STAGE(PG8_SB(1, 1), cB + hstepB + kstep, voffB);
        PG8_WAIT_V(6); PG8_BAR;
    } else {
        PG8_STAGE(PG8_SB(0, 0), cB, voffB); PG8_STAGE(PG8_SA(0, 0), cA, voffA); PG8_STAGE(PG8_SB(0, 1), cB + hstepB, voffB); PG8_STAGE(PG8_SA(0, 1), cA + hstepA, voffA);
        if (wr == 1) PG8_BAR;
        PG8_WAIT_V(4); PG8_BAR;
        PG8_STAGE(PG8_SB(1, 0), cB + kstep, voffB); PG8_STAGE(PG8_SA(1, 0), cA + kstep, voffA); PG8_STAGE(PG8_SB(1, 1), cB + hstepB + kstep, voffB);
        PG8_WAIT_V(6); PG8_BAR;
    }
    for (;;) {
        const bool has_next = S.next(ui + 1, nxt);
        const char* nA = has_next ? (const char*)g.A + (size_t)nxt.pm * tstepA : cA; const char* nB = has_next ? (const char*)g.Bt + (size_t)nxt.pn * tstepB : cB;
        for (int t = 0; t < nt; t += 2) {
            const bool last = (t == nt - 2);
            const char* a1 = cA + (size_t)(t + 1) * kstep;
            const char* a2 = last ? nA : cA + (size_t)(t + 2) * kstep; const char* b2 = last ? nB : cB + (size_t)(t + 2) * kstep;
            const char* a3 = a2 + kstep; const char* b3 = b2 + kstep;
            if (last && has_next) S.a_ready(nxt);
            if constexpr (SP2) {
            PG8_LDB(B0, 0, 0); PG8_LDB(B1, 0, 1); PG8_SCHED; PG8_LDA(At, 0, 0); PG8_STAGE(PG8_SA(1, 1), a1 + hstepA, voffA);
            PG8_WAIT_V(8); PG8_WAIT_L(0); PG8_BAR; PG8_MMA(0, 0, At, B0); PG8_MMA(0, 1, At, B1); PG8_BAR; PG8_SCHED;
            PG8_LDA(At, 0, 1); PG8_STAGE(PG8_SB(0, 0), b2, voffB); PG8_STAGE(PG8_SB(0, 1), b2 + hstepB, voffB); PG8_STAGE(PG8_SA(0, 0), a2, voffA);
            PG8_WAIT_V(8); PG8_WAIT_L(0); PG8_BAR; PG8_MMA(1, 0, At, B0); PG8_MMA(1, 1, At, B1); PG8_BAR; PG8_SCHED;
            PG8_LDB(B0, 1, 0); PG8_LDB(B1, 1, 1); PG8_SCHED; PG8_LDA(At, 1, 0); PG8_STAGE(PG8_SA(0, 1), a2 + hstepA, voffA);
            PG8_WAIT_V(8); PG8_WAIT_L(0); PG8_BAR; PG8_MMA(0, 0, At, B0); PG8_MMA(0, 1, At, B1); PG8_BAR; PG8_SCHED;
            PG8_LDA(At, 1, 1); PG8_STAGE(PG8_SB(1, 0), b3, voffB); PG8_STAGE(PG8_SB(1, 1), b3 + hstepB, voffB); PG8_STAGE(PG8_SA(1, 0), a3, voffA);
            PG8_WAIT_V(8); PG8_WAIT_L(0); PG8_BAR; PG8_MMA(1, 0, At, B0); PG8_MMA(1, 1, At, B1); PG8_BAR; PG8_SCHED;
            } else {
            PG8_LDB(B0, 0, 0); PG8_SCHED; PG8_LDA(At, 0, 0); PG8_STAGE(PG8_SA(1, 1), a1 + hstepA, voffA);
            PG8_WAIT_L(8); PG8_BAR; PG8_WAIT_L(0); PG8_MMA(0, 0, At, B0); PG8_BAR; PG8_SCHED;
            PG8_LDB(B1, 0, 1); PG8_STAGE(PG8_SB(0, 0), b2, voffB);
            PG8_BAR; PG8_WAIT_L(0); PG8_MMA(0, 1, At, B1); PG8_BAR;
            PG8_LDA(At, 0, 1); PG8_STAGE(PG8_SA(0, 0), a2, voffA);
            PG8_BAR; PG8_WAIT_L(0); PG8_MMA(1, 0, At, B0); PG8_BAR; PG8_SCHED;
            PG8_STAGE(PG8_SB(0, 1), b2 + hstepB, voffB);
            PG8_WAIT_V(6); PG8_BAR; PG8_MMA(1, 1, At, B1); PG8_BAR;
            PG8_LDB(B0, 1, 0); PG8_SCHED; PG8_LDA(At, 1, 0); PG8_STAGE(PG8_SA(0, 1), a2 + hstepA, voffA);
            PG8_WAIT_L(8); PG8_BAR; PG8_WAIT_L(0); PG8_MMA(0, 0, At, B0); PG8_BAR; PG8_SCHED;
            PG8_LDB(B1, 1, 1); PG8_STAGE(PG8_SB(1, 0), b3, voffB);
            PG8_BAR; PG8_WAIT_L(0); PG8_MMA(0, 1, At, B1); PG8_BAR;
            PG8_LDA(At, 1, 1); PG8_STAGE(PG8_SA(1, 0), a3, voffA);
            PG8_BAR; PG8_WAIT_L(0); PG8_MMA(1, 0, At, B0); PG8_BAR; PG8_SCHED;
            PG8_STAGE(PG8_SB(1, 1), b3 + hstepB, voffB);
            PG8_WAIT_V(6); PG8_BAR; PG8_MMA(1, 1, At, B1); PG8_BAR;
            }
        }
        if constexpr (ALIGN_EPI) { if (wr == 0) PG8_BAR; }
        if constexpr (!Epi::AFTER_DRAIN) { E(acc, cur, wr, wc, fr, fq); S.done(cur); }
        if (!has_next) break;
#pragma unroll
        for (int a = 0; a < 2; ++a)
#pragma unroll
            for (int b = 0; b < 2; ++b)
#pragma unroll
                for (int m = 0; m < 4; ++m)
#pragma unroll
                    for (int n = 0; n < 2; ++n) acc[a][b][m][n] = (f32x4){0.f, 0.f, 0.f, 0.f};
        cur = nxt; cA = nA; cB = nB; ++ui;
        if constexpr (ALIGN_EPI) { if (wr == 1) PG8_BAR; }
    }
    PG8_WAIT_V(0);
    if constexpr (!ALIGN_EPI) { if (wr == 0) PG8_BAR; }
    PG8_BAR;
    if constexpr (Epi::AFTER_DRAIN) { E.fused(acc, cur, wr, wc, fr, fq, lds, wid, lane); S.done(cur); }
#undef PG8_SA
#undef PG8_SB
#undef PG8_STAGE
#undef PG8_LDA
#undef PG8_LDB
#undef PG8_MMA
#undef PG8_WAIT_V
#undef PG8_WAIT_L
#undef PG8_BAR
#undef PG8_SCHED
}
}

#define LAS __attribute__((address_space(3)))
using pg8::bf16_t; using pg8::f32x4; using pg8::u32x4; using pg8::bf16x8; using pg8::Unit; using pg8::BM; using pg8::HALF;
typedef unsigned u32x2 __attribute__((ext_vector_type(2)));

constexpr int MROWS = 32768, DM = 1024, SEQ = 8192, NBATCH = 4, DFF = 2816;
constexpr int NCHUNK = MROWS / 64;
constexpr float EPS = 1e-6f;
constexpr float QSCALE = 0.07216878364870322f * 1.4426950408889634f;
constexpr int N1 = 3840, NGATE = 2048, NUQ = 1536, NUKV = 2048, NGU = 5632;
constexpr size_t MiB = 1u << 20;
constexpr size_t WS_SS = 488 * MiB;
constexpr size_t WS_CD = 3 * MiB;
constexpr size_t WS_COS = 4 * MiB, WS_SIN = 8 * MiB;
constexpr size_t WS_WB = 12 * MiB;
constexpr size_t WS_H = 52 * MiB;
constexpr size_t WS_QG = 116 * MiB, WS_KG = 148 * MiB;
constexpr size_t WS_V = 180 * MiB;
constexpr size_t WS_G = 244 * MiB;
constexpr size_t WS_MQ = 308 * MiB, WS_QR = 372 * MiB;
constexpr size_t WS_KDT = 404 * MiB;
constexpr size_t WS_MISC = 436 * MiB;
constexpr size_t WS_CKV = 468 * MiB;
constexpr size_t WS_KPE = 484 * MiB;
constexpr size_t WS_END = 504 * MiB;
constexpr size_t WO_W1 = 0, WO_GATE = WO_W1 + (size_t)N1 * 1024, WO_UQ = WO_GATE + (size_t)NGATE * 1024, WO_UKV = WO_UQ + (size_t)NUQ * 512,
                 WO_OGLA = WO_UKV + (size_t)NUKV * 256, WO_OMLA = WO_OGLA + 1024 * 1024, WO_OUT = WO_OMLA + 1024 * 1024, WO_GU = WO_OUT + 1024 * 1024,
                 WO_DOWN = WO_GU + (size_t)NGU * 1024, WO_END = WO_DOWN + (size_t)1024 * DFF;
static_assert(WO_END * 2 <= 40 * MiB, "weights fit");

typedef float f32x2_t __attribute__((ext_vector_type(2))); typedef __bf16 bf16x2_t __attribute__((ext_vector_type(2)));
__device__ __forceinline__ unsigned pk2(float lo, float hi) { f32x2_t v = {lo, hi}; bf16x2_t b = __builtin_convertvector(v, bf16x2_t); return __builtin_bit_cast(unsigned, b); }
__device__ __forceinline__ u32x4 pack8(const f32x4 a, const f32x4 b) { u32x4 w; w.x = pk2(a[0], a[1]); w.y = pk2(a[2], a[3]); w.z = pk2(b[0], b[1]); w.w = pk2(b[2], b[3]); return w; }
__device__ __forceinline__ float bf_lo(unsigned w) { return __uint_as_float(w << 16); }
__device__ __forceinline__ float bf_hi(unsigned w) { return __uint_as_float(w & 0xffff0000u); }
__device__ __forceinline__ float bf1(bf16_t v) { return __uint_as_float(((unsigned)v) << 16); }
__device__ __forceinline__ float sigm(float x) { return __builtin_amdgcn_rcpf(1.f + __builtin_amdgcn_exp2f(x * -1.4426950408889634f)); }
__device__ __forceinline__ float wave_sum(float v) {
#pragma unroll
    for (int o = 1; o < 64; o <<= 1) v += __shfl_xor(v, o);
    return v;
}
__device__ __forceinline__ float dot4(const f32x4 a) { return (a[0] * a[0] + a[1] * a[1]) + (a[2] * a[2] + a[3] * a[3]); }

typedef f32x4 acc_t[2][2][4][2];

struct EpiG1 {
    static constexpr bool PERM = true, AFTER_DRAIN = false;
    bf16_t *Qg, *Kg, *V, *G, *CKV, *MISC; float *SSQ, *SSKV;
    __device__ __forceinline__ void operator()(const acc_t& acc, const Unit& u, int wr, int wc, int fr, int fq) const {
        const int pn = u.pn; bf16_t* base; int ld, c0;
        if (pn < 2) { base = Qg; ld = 512; c0 = pn * 256; }
        else if (pn < 4) { base = Kg; ld = 512; c0 = (pn - 2) * 256; }
        else if (pn < 8) { base = V; ld = 1024; c0 = (pn - 4) * 256; }
        else if (pn < 12) { base = G; ld = 1024; c0 = (pn - 8) * 256; }
        else if (pn == 12) { base = CKV; ld = 256; c0 = 0; }
        else { base = MISC; ld = 512; c0 = (pn - 13) * 256; }
        float* ssp = (pn == 12) ? (SSKV + wc) : ((pn >= 13) ? (SSQ + (pn - 13) * 4 + wc) : nullptr); const int sst = (pn == 12) ? 4 : 8;
        const bool both = (pn != 14);
        const int row0 = u.pm * BM + wr * 64 + fr, tc = wc * 32 + 8 * fq;
#pragma unroll
        for (int ai = 0; ai < 2; ++ai)
#pragma unroll
            for (int m = 0; m < 4; ++m) {
                const int row = row0 + ai * HALF + m * 16; bf16_t* rowp = base + (size_t)row * ld + c0 + tc; bf16_t* rowp1 = rowp + HALF;
                if (pn < 2) {
                    const int t = row & 63, ck = row >> 6;
#pragma unroll
                    for (int bj = 0; bj < 2; ++bj) { const int c = c0 + tc + bj * HALF, hh = c >> 7, j8 = (c & 127) >> 3, L = ((((t >> 4) * 4 + (j8 >> 2)) * 4 + (j8 & 3)) * 16 + (t & 15)) * 8;
                        bf16_t* p = Qg + (size_t)(ck * 64 + (L >> 7)) * 512 + hh * 128 + (L & 127); if (bj == 0) rowp = p; else rowp1 = p; }
                } else if (pn >= 4 && pn < 8) {
                    const int b_ = row >> 13, t = row & (SEQ - 1);
#pragma unroll
                    for (int bj = 0; bj < 2; ++bj) { const int c = c0 + tc + bj * HALF, hh = c >> 8, dvv = c & 255;
                        bf16_t* p = V + ((size_t)(((b_ * 4 + hh) * 16 + (dvv >> 4))) * SEQ + t) * 16 + (dvv & 8); if (bj == 0) rowp = p; else rowp1 = p; }
                }
                *(u32x4*)(rowp) = pack8(acc[ai][0][m][0], acc[ai][0][m][1]);
                *(u32x4*)(rowp1) = pack8(acc[ai][1][m][0], acc[ai][1][m][1]);
                if (ssp) {
                    float s = dot4(acc[ai][0][m][0]) + dot4(acc[ai][0][m][1]);
                    if (both) s += dot4(acc[ai][1][m][0]) + dot4(acc[ai][1][m][1]);
                    s += __shfl_xor(s, 16); s += __shfl_xor(s, 32);
                    if (fq == 0) ssp[(size_t)row * sst] = s;
                }
            }
    }
};
struct EpiQ {
    static constexpr bool PERM = true, AFTER_DRAIN = false;
    bf16_t *QN, *QR; const float* SSQ;
    __device__ __forceinline__ void operator()(const acc_t& acc, const Unit& u, int wr, int wc, int fr, int fq) const {
        const int pn = u.pn, row0 = u.pm * BM + wr * 64 + fr; bf16_t* base = (pn < 4) ? QN : QR; const int sh = (pn < 4) ? 10 : 9; const int c0 = (pn & 3) * 256 + wc * 32 + 8 * fq;
#pragma unroll
        for (int ai = 0; ai < 2; ++ai)
#pragma unroll
            for (int m = 0; m < 4; ++m) {
                const int row = row0 + ai * HALF + m * 16; const f32x4 q0 = *(const f32x4*)(SSQ + (size_t)row * 8), q1 = *(const f32x4*)(SSQ + (size_t)row * 8 + 4);
                const float rs = rsqrtf((((q0[0] + q0[1]) + (q0[2] + q0[3])) + ((q1[0] + q1[1]) + (q1[2] + q1[3]))) * (1.f / 384.f) + EPS) * QSCALE;
                bf16_t* rowp = base + ((size_t)row << sh) + c0;
                *(u32x4*)(rowp) = pack8(acc[ai][0][m][0] * rs, acc[ai][0][m][1] * rs);
                *(u32x4*)(rowp + HALF) = pack8(acc[ai][1][m][0] * rs, acc[ai][1][m][1] * rs);
                asm volatile("" ::: "memory");
            }
    }
};
struct EpiKV {
    static constexpr bool PERM = true, AFTER_DRAIN = false;
    bf16_t *KN, *VV; const float* SSKV;
    __device__ __forceinline__ void operator()(const acc_t& acc, const Unit& u, int wr, int wc, int fr, int fq) const {
        const int pn = u.pn, row0 = u.pm * BM + wr * 64 + fr; bf16_t* base = (pn < 4) ? KN : VV; const int c0 = (pn & 3) * 256 + wc * 32 + 8 * fq;
#pragma unroll
        for (int ai = 0; ai < 2; ++ai)
#pragma unroll
            for (int m = 0; m < 4; ++m) {
                const int row = row0 + ai * HALF + m * 16; const f32x4 q0 = *(const f32x4*)(SSKV + (size_t)row * 4); const float rs = rsqrtf(((q0[0] + q0[1]) + (q0[2] + q0[3])) * (1.f / 256.f) + EPS);
                bf16_t* rowp = base + (size_t)row * 1024 + c0;
                *(u32x4*)(rowp) = pack8(acc[ai][0][m][0] * rs, acc[ai][0][m][1] * rs);
                *(u32x4*)(rowp + HALF) = pack8(acc[ai][1][m][0] * rs, acc[ai][1][m][1] * rs);
                asm volatile("" ::: "memory");
            }
    }
};
template <bool SS> struct EpiStore {
    static constexpr bool PERM = true, AFTER_DRAIN = false;
    bf16_t* O; int ldc; float* ssp;
    __device__ __forceinline__ void operator()(const acc_t& acc, const Unit& u, int wr, int wc, int fr, int fq) const {
        const int row0 = u.pm * BM + wr * 64 + fr, c0 = u.pn * 256 + wc * 32 + 8 * fq;
#pragma unroll
        for (int ai = 0; ai < 2; ++ai)
#pragma unroll
            for (int m = 0; m < 4; ++m) {
                const int row = row0 + ai * HALF + m * 16; bf16_t* rowp = O + (size_t)row * ldc + c0;
                *(u32x4*)(rowp) = pack8(acc[ai][0][m][0], acc[ai][0][m][1]);
                *(u32x4*)(rowp + HALF) = pack8(acc[ai][1][m][0], acc[ai][1][m][1]);
                if (SS) {
                    float s = dot4(acc[ai][0][m][0]) + dot4(acc[ai][0][m][1]) + dot4(acc[ai][1][m][0]) + dot4(acc[ai][1][m][1]);
                    s += __shfl_xor(s, 16); s += __shfl_xor(s, 32);
                    if (fq == 0) ssp[(size_t)row * 16 + u.pn * 4 + wc] = s;
                }
            }
    }
};
struct EpiMerge {
    static constexpr bool PERM = true, AFTER_DRAIN = false;
    const bf16_t *YA, *YB; const float* bg; bf16_t* MIX;
    __device__ __forceinline__ void operator()(const acc_t& acc, const Unit& u, int wr, int wc, int fr, int fq) const {
        const int row0 = u.pm * BM + wr * 64 + fr, ch = u.pn * 128 + wc * 32 + 8 * fq;
        const f32x4 ba0 = *(const f32x4*)(bg + ch), ba1 = *(const f32x4*)(bg + ch + 4), bb0 = *(const f32x4*)(bg + 1024 + ch), bb1 = *(const f32x4*)(bg + 1024 + ch + 4);
#pragma unroll
        for (int ai = 0; ai < 2; ++ai)
#pragma unroll
            for (int m = 0; m < 4; ++m) {
                const size_t off = (size_t)(row0 + ai * HALF + m * 16) * 1024 + ch;
                const u32x4 ya = *(const u32x4*)(YA + off), yb = *(const u32x4*)(YB + off);
                const f32x4 ga0 = acc[ai][0][m][0] + ba0, ga1 = acc[ai][0][m][1] + ba1, gb0 = acc[ai][1][m][0] + bb0, gb1 = acc[ai][1][m][1] + bb1;
                f32x4 o0, o1;
                o0[0] = sigm(ga0[0]) * bf_lo(ya.x) + sigm(gb0[0]) * bf_lo(yb.x); o0[1] = sigm(ga0[1]) * bf_hi(ya.x) + sigm(gb0[1]) * bf_hi(yb.x);
                o0[2] = sigm(ga0[2]) * bf_lo(ya.y) + sigm(gb0[2]) * bf_lo(yb.y); o0[3] = sigm(ga0[3]) * bf_hi(ya.y) + sigm(gb0[3]) * bf_hi(yb.y);
                o1[0] = sigm(ga1[0]) * bf_lo(ya.z) + sigm(gb1[0]) * bf_lo(yb.z); o1[1] = sigm(ga1[1]) * bf_hi(ya.z) + sigm(gb1[1]) * bf_hi(yb.z);
                o1[2] = sigm(ga1[2]) * bf_lo(ya.w) + sigm(gb1[2]) * bf_lo(yb.w); o1[3] = sigm(ga1[3]) * bf_hi(ya.w) + sigm(gb1[3]) * bf_hi(yb.w);
                *(u32x4*)(MIX + off) = pack8(o0, o1);
                asm volatile("" ::: "memory");
            }
    }
};
struct EpiSwiglu {
    static constexpr bool PERM = true, AFTER_DRAIN = false;
    bf16_t* HID;
    __device__ __forceinline__ void operator()(const acc_t& acc, const Unit& u, int wr, int wc, int fr, int fq) const {
        const int row0 = u.pm * BM + wr * 64 + fr, ch = u.pn * 128 + wc * 32 + 8 * fq;
#pragma unroll
        for (int ai = 0; ai < 2; ++ai)
#pragma unroll
            for (int m = 0; m < 4; ++m) {
                f32x4 o0, o1;
#pragma unroll
                for (int e = 0; e < 4; ++e) { const float g0 = acc[ai][0][m][0][e], g1 = acc[ai][0][m][1][e];
                    o0[e] = g0 * sigm(g0) * acc[ai][1][m][0][e]; o1[e] = g1 * sigm(g1) * acc[ai][1][m][1][e]; }
                *(u32x4*)(HID + (size_t)(row0 + ai * HALF + m * 16) * DFF + ch) = pack8(o0, o1);
            }
    }
};
template <class Epi> __device__ __forceinline__ void run_gemm(LAS unsigned char* lds, const bf16_t* A, int lda, const bf16_t* Bt, int N, int K, const Epi& E) {
    pg8::Gemm g{A, Bt, MROWS, N, K, lda}; pg8::StaticOrder S; S.init(MROWS, N, (int)gridDim.x, (int)blockIdx.x);
    pg8::gemm_phase<Epi, pg8::StaticOrder, true, true>(lds, g, S, E);
}

__device__ __forceinline__ void transpose_item(const float* W, int ldw, int col0, int nvalid, const float* kg, bf16_t* WT, int K, int drow0, int k0, LAS float* scr, int lane) {
#pragma unroll
    for (int i = 0; i < 8; ++i) { const int kk = 8 * i + (lane >> 3), c = 4 * (lane & 7);
        f32x4 v = (c < nvalid) ? *(const f32x4*)(W + (size_t)(k0 + kk) * ldw + col0 + c) : (f32x4){0.f, 0.f, 0.f, 0.f}; if (kg) v = v * kg[k0 + kk];
        LAS float* d = scr + kk * 33 + c; d[0] = v[0]; d[1] = v[1]; d[2] = v[2]; d[3] = v[3]; }
    asm volatile("s_waitcnt lgkmcnt(0)" ::: "memory");
    const int c8 = lane & 7;
#pragma unroll
    for (int j = 0; j < 4; ++j) { const int n = (lane >> 3) + 8 * j; const LAS float* s = scr + (8 * c8) * 33 + n;
        u32x4 o; o.x = pk2(s[0 * 33], s[1 * 33]); o.y = pk2(s[2 * 33], s[3 * 33]); o.z = pk2(s[4 * 33], s[5 * 33]); o.w = pk2(s[6 * 33], s[7 * 33]);
        *(u32x4*)(WT + (size_t)(drow0 + n) * K + k0 + 8 * c8) = o; }
    asm volatile("s_waitcnt lgkmcnt(0)" ::: "memory");
}
struct Ins { const float *x; const int* pos; const float *pre_mix, *w_in, *w_a2, *b_a2, *gla_norm, *w_o_gla, *q_norm, *w_uq, *kv_norm, *w_ukv, *w_o_mla, *w_gate, *b_gate, *w_out,
             *post_mix, *pre_ffn, *w_fg, *w_fu, *w_fd, *post_ffn; };
constexpr int IT_W1 = (N1 / 32) * 16, IT_GATE = (NGATE / 32) * 16, IT_UQ = (NUQ / 32) * 8, IT_UKV = (NUKV / 32) * 4, IT_SQ = 32 * 16, IT_GU = (NGU / 32) * 16, IT_DOWN = 32 * 44;
constexpr int IT_TOTAL = IT_W1 + IT_GATE + IT_UQ + IT_UKV + 3 * IT_SQ + IT_GU + IT_DOWN;
__device__ __forceinline__ void weight_item(int it, const Ins& I, bf16_t* WB, LAS float* scr, int lane) {
    int r = it;
    if (r < IT_W1) { const int g = r / 16, kb = r % 16, n0 = g * 32; int col, nv = 32;
        if (n0 < 3072) col = n0; else if (n0 < 3328) col = 3472 + (n0 - 3072); else if (n0 < 3712) col = 3088 + (n0 - 3328); else if (n0 < 3776) col = 3728 + (n0 - 3712);
        else if (n0 == 3776) { col = 3072; nv = 16; } else { col = 0; nv = 0; }
        transpose_item(I.w_in, 3792, col, nv, nullptr, WB + WO_W1, 1024, n0, kb * 64, scr, lane); return; }
    r -= IT_W1;
    if (r < IT_GATE) { const int g = r / 16, kb = r % 16, n0 = g * 32, t = n0 >> 8, wi = n0 & 255; const int col = (wi < 128) ? (128 * t + wi) : (1024 + 128 * t + wi - 128);
        transpose_item(I.w_gate, 2048, col, 32, nullptr, WB + WO_GATE, 1024, n0, kb * 64, scr, lane); return; }
    r -= IT_GATE;
    if (r < IT_UQ) { const int g = r / 8, kb = r % 8, n0 = g * 32; int col;
        if (n0 < 1024) col = (n0 >> 7) * 192 + (n0 & 127); else { const int q = n0 - 1024; col = (q >> 6) * 192 + 128 + (q & 63); }
        if (kb < 6) transpose_item(I.w_uq, 1536, col, 32, I.q_norm, WB + WO_UQ, 512, n0, kb * 64, scr, lane); else transpose_item(I.w_uq, 1536, col, 0, nullptr, WB + WO_UQ, 512, n0, kb * 64, scr, lane); return; }
    r -= IT_UQ;
    if (r < IT_UKV) { const int g = r / 4, kb = r % 4, n0 = g * 32; const int q = n0 & 1023, col = (q >> 7) * 256 + (n0 >= 1024 ? 128 : 0) + (q & 127);
        transpose_item(I.w_ukv, 2048, col, 32, I.kv_norm, WB + WO_UKV, 256, n0, kb * 64, scr, lane); return; }
    r -= IT_UKV;
    if (r < IT_SQ) { const int g = r / 16, kb = r % 16; transpose_item(I.w_o_gla, 1024, g * 32, 32, nullptr, WB + WO_OGLA, 1024, g * 32, kb * 64, scr, lane); return; }
    r -= IT_SQ;
    if (r < IT_SQ) { const int g = r / 16, kb = r % 16; transpose_item(I.w_o_mla, 1024, g * 32, 32, nullptr, WB + WO_OMLA, 1024, g * 32, kb * 64, scr, lane); return; }
    r -= IT_SQ;
    if (r < IT_SQ) { const int g = r / 16, kb = r % 16; transpose_item(I.w_out, 1024, g * 32, 32, nullptr, WB + WO_OUT, 1024, g * 32, kb * 64, scr, lane); return; }
    r -= IT_SQ;
    if (r < IT_GU) { const int g = r / 16, kb = r % 16, n0 = g * 32, t = n0 >> 8, wi = n0 & 255;
        if (wi < 128) transpose_item(I.w_fg, DFF, 128 * t + wi, 32, nullptr, WB + WO_GU, 1024, n0, kb * 64, scr, lane); else transpose_item(I.w_fu, DFF, 128 * t + wi - 128, 32, nullptr, WB + WO_GU, 1024, n0, kb * 64, scr, lane); return; }
    r -= IT_GU;
    { const int g = r / 44, kb = r % 44; transpose_item(I.w_fd, 1024, g * 32, 32, nullptr, WB + WO_DOWN, DFF, g * 32, kb * 64, scr, lane); }
}
__device__ __forceinline__ void rms_row_to_bf16(const float* xrow, const float* gain, bf16_t* orow, int lane) {
    const f32x4* xr = (const f32x4*)xrow + lane; const f32x4* gr = (const f32x4*)gain + lane;
    f32x4 v[4]; float s = 0.f;
#pragma unroll
    for (int j = 0; j < 4; ++j) { v[j] = xr[64 * j]; s += dot4(v[j]); }
    const float rs = rsqrtf(wave_sum(s) * (1.f / 1024.f) + EPS);
    u32x2* o8 = (u32x2*)orow + lane;
#pragma unroll
    for (int j = 0; j < 4; ++j) { const f32x4 g = gr[64 * j]; u32x2 w; w.x = pk2(v[j][0] * rs * g[0], v[j][1] * rs * g[1]); w.y = pk2(v[j][2] * rs * g[2], v[j][3] * rs * g[3]); o8[64 * j] = w; }
}

__device__ __forceinline__ void gla_prep_item(int item, const bf16_t* Kg, const bf16_t* MISC, const float* w_a2, const float* b_a2, bf16_t* KDT, float* CD, LAS float* part) {
    int tid_ = threadIdx.x; asm volatile("" : "+v"(tid_));
    const int tid = tid_, j = tid & 127, tg = tid >> 7, cgi = item >> 2, h = item & 3, r0 = cgi * 64;
    float w[16];
#pragma unroll
    for (int r = 0; r < 16; ++r) w[r] = w_a2[r * 512 + h * 128 + j];
    const float bias = b_a2[h * 128 + j];
    float bcum[16]; float cum = 0.f;
#pragma unroll
    for (int tt = 0; tt < 16; ++tt) {
        const int row = r0 + tg * 16 + tt;
        const u32x4 ha0 = *(const u32x4*)(MISC + (size_t)row * 512 + 448), ha1 = *(const u32x4*)(MISC + (size_t)row * 512 + 456);
        float z = bias;
        z += bf_lo(ha0.x) * w[0] + bf_hi(ha0.x) * w[1] + bf_lo(ha0.y) * w[2] + bf_hi(ha0.y) * w[3] + bf_lo(ha0.z) * w[4] + bf_hi(ha0.z) * w[5] + bf_lo(ha0.w) * w[6] + bf_hi(ha0.w) * w[7];
        z += bf_lo(ha1.x) * w[8] + bf_hi(ha1.x) * w[9] + bf_lo(ha1.y) * w[10] + bf_hi(ha1.y) * w[11] + bf_lo(ha1.z) * w[12] + bf_hi(ha1.z) * w[13] + bf_lo(ha1.w) * w[14] + bf_hi(ha1.w) * w[15];
        const float ls = fminf(z, 0.f) - __logf(1.f + __expf(-fabsf(z)));
        cum += ls * (1.f / 16.f); bcum[tt] = cum;
    }
    part[tg * 128 + j] = cum;
    __syncthreads();
    const float p0 = part[j], p1 = part[128 + j], p2 = part[256 + j], p3 = part[384 + j];
    const float off = (tg > 0 ? p0 : 0.f) + (tg > 1 ? p1 : 0.f) + (tg > 2 ? p2 : 0.f), total = (p0 + p1) + (p2 + p3);
    unsigned pk[8];
#pragma unroll
    for (int tt = 0; tt < 16; tt += 2) {
        const int row = r0 + tg * 16 + tt;
        const float k0 = bf1(Kg[(size_t)row * 512 + h * 128 + j]) * __expf(total - (bcum[tt] + off));
        const float k1 = bf1(Kg[(size_t)(row + 1) * 512 + h * 128 + j]) * __expf(total - (bcum[tt + 1] + off));
        pk[tt >> 1] = pk2(k0, k1);
    }
    bf16_t* dst = KDT + (size_t)item * 8192 + (((((j >> 4) * 2 + (tg >> 1)) * 4 + (tg & 1) * 2) * 16 + (j & 15)) * 8);
    *(u32x4*)dst = (u32x4){pk[0], pk[1], pk[2], pk[3]}; *(u32x4*)(dst + 128) = (u32x4){pk[4], pk[5], pk[6], pk[7]};
    if (tg == 0) CD[(size_t)item * 128 + j] = __expf(total);
    __syncthreads();
}

struct GlaOps { bf16x8 a0, a1, vp, q0, q1, q2, q3; f32x4 d; };
__device__ __forceinline__ void gla_load(GlaOps& o, int cgi, int h, int s, int w, int fr, int fq, const bf16_t* Qg, const bf16_t* KDT, const float* CD, const bf16_t* Vb) {
    const int r0 = cgi * 64;
    const bf16_t* kdt = KDT + (size_t)(cgi * 4 + h) * 8192 + w * 1024 + fq * 128 + fr * 8;
    o.a0 = *(const bf16x8*)kdt; o.a1 = *(const bf16x8*)(kdt + 512);
    { const int cv = (cgi + 1 < (cgi | 127) ? cgi + 1 : (cgi | 127)), lv = (fq == 0) ? fr : 0;
      o.vp = *(const bf16x8*)(Vb + ((size_t)(((cgi >> 7) * 4 + h) * 16 + s) * SEQ + (size_t)(cv & 127) * 64) * 16 + w * 128 + lv * 8); }
    o.d = *(const f32x4*)(CD + (size_t)(cgi * 4 + h) * 128 + 16 * w + 4 * fq);
    const int fq2 = (w < 4) ? fq : 0, fr2 = (w < 4) ? fr : 0;
    const bf16_t* qp = Qg + (size_t)(r0 + 16 * (w & 3) + fq2) * 512 + h * 128 + fr2 * 8;
    o.q0 = *(const bf16x8*)qp; o.q1 = *(const bf16x8*)(qp + 4 * 512); o.q2 = *(const bf16x8*)(qp + 8 * 512); o.q3 = *(const bf16x8*)(qp + 12 * 512);
}
__device__ __forceinline__ void gla_step(const GlaOps& o, f32x4& S, int c, int w, int fr, int fq, LAS unsigned char* lds) {
    const LAS bf16_t* VL = (const LAS bf16_t*)(lds + 8704) + (c & 1) * 1024;
    typedef short v4i16_t __attribute__((ext_vector_type(4)));
    const LAS bf16_t* vtp = VL + (8 * fq + ((fr >> 2) & 3)) * 16 + (fr & 3) * 4;
    const v4i16_t t0 = __builtin_amdgcn_ds_read_tr16_b64_v4i16((LAS v4i16_t*)(vtp)), t1 = __builtin_amdgcn_ds_read_tr16_b64_v4i16((LAS v4i16_t*)(vtp + 64));
    const v4i16_t t2 = __builtin_amdgcn_ds_read_tr16_b64_v4i16((LAS v4i16_t*)(vtp + 512)), t3 = __builtin_amdgcn_ds_read_tr16_b64_v4i16((LAS v4i16_t*)(vtp + 576));
    const bf16x8 vb0 = {t0[0], t0[1], t0[2], t0[3], t1[0], t1[1], t1[2], t1[3]}, vb1 = {t2[0], t2[1], t2[2], t2[3], t3[0], t3[1], t3[2], t3[3]};
    S = S * o.d;
    S = __builtin_amdgcn_mfma_f32_16x16x32_bf16(o.a0, vb0, S, 0, 0, 0);
    S = __builtin_amdgcn_mfma_f32_16x16x32_bf16(o.a1, vb1, S, 0, 0, 0);
    LAS bf16_t* T = (LAS bf16_t*)lds + (c & 1) * (16 * 136);
    { u32x2 wv; wv.x = pk2(S[0], S[1]); wv.y = pk2(S[2], S[3]); *(LAS u32x2*)(T + fr * 136 + 16 * w + 4 * fq) = wv; }
    if (fq == 0) *(LAS bf16x8*)((LAS bf16_t*)(lds + 8704) + ((c + 1) & 1) * 1024 + w * 128 + fr * 8) = o.vp;
    __syncthreads();
    if (w < 4) {
        const LAS bf16_t* tp = T + fr * 136 + 8 * fq;
        const bf16x8 s0 = *(const LAS bf16x8*)tp, s1 = *(const LAS bf16x8*)(tp + 32), s2 = *(const LAS bf16x8*)(tp + 64), s3 = *(const LAS bf16x8*)(tp + 96);
        f32x4 v = {0.f, 0.f, 0.f, 0.f};
        v = __builtin_amdgcn_mfma_f32_16x16x32_bf16(o.q0, s0, v, 0, 0, 0);
        v = __builtin_amdgcn_mfma_f32_16x16x32_bf16(o.q1, s1, v, 0, 0, 0);
        v = __builtin_amdgcn_mfma_f32_16x16x32_bf16(o.q2, s2, v, 0, 0, 0);
        v = __builtin_amdgcn_mfma_f32_16x16x32_bf16(o.q3, s3, v, 0, 0, 0);
        v = v * 0.08838834764831845f;
        LAS bf16_t* OL = (LAS bf16_t*)(lds + 16384) + (c & 7) * 1024;
#pragma unroll
        for (int r = 0; r < 4; ++r) OL[(16 * w + 4 * fq + r) * 16 + fr] = (bf16_t)(pk2(v[r], 0.f) & 0xffffu);
    }
}
__device__ __forceinline__ void gla_flush(int c, int u, int tid, bf16_t* OGT, float* SSG, LAS unsigned char* lds) {
    __syncthreads();
    const size_t t0 = (size_t)u * SEQ + (size_t)(c - 7) * 64;
    const u32x4 v0 = *(const LAS u32x4*)(lds + 16384 + tid * 32), v1 = *(const LAS u32x4*)(lds + 16384 + tid * 32 + 16);
    *(u32x4*)(OGT + (t0 + tid) * 16) = v0; *(u32x4*)(OGT + (t0 + tid) * 16 + 8) = v1;
}
__device__ __forceinline__ void gla_unit(int u, const bf16_t* Qg, const bf16_t* KDT, const float* CD, const bf16_t* Vb, bf16_t* OGT, float* SSG, LAS unsigned char* lds) {
    int tid_ = threadIdx.x; asm volatile("" : "+v"(tid_));
    const int tid = tid_, lane = tid & 63, w = __builtin_amdgcn_readfirstlane(tid >> 6), fr = lane & 15, fq = lane >> 4;
    const int s = u & 15, h = (u >> 4) & 3, b = u >> 6;
    f32x4 S = {0.f, 0.f, 0.f, 0.f};
    GlaOps A, B, C, D;
    const int c0 = b * 128;
    gla_load(A, c0, h, s, w, fr, fq, Qg, KDT, CD, Vb); gla_load(B, c0 + 1, h, s, w, fr, fq, Qg, KDT, CD, Vb);
    gla_load(C, c0 + 2, h, s, w, fr, fq, Qg, KDT, CD, Vb); gla_load(D, c0 + 3, h, s, w, fr, fq, Qg, KDT, CD, Vb);
    { const int lv = (fq == 0) ? fr : 0;
      const bf16x8 v0 = *(const bf16x8*)(Vb + ((size_t)u * SEQ) * 16 + w * 128 + lv * 8);
      if (fq == 0) *(LAS bf16x8*)((LAS bf16_t*)(lds + 8704) + w * 128 + fr * 8) = v0; }
    __syncthreads();
    for (int c = 0; c < 128; c += 8) {
        const int n0 = c0 + c + 4, n1 = c0 + (c + 8 < 128 ? c + 8 : 124);
        gla_step(A, S, c, w, fr, fq, lds);     gla_load(A, n0, h, s, w, fr, fq, Qg, KDT, CD, Vb);
        gla_step(B, S, c + 1, w, fr, fq, lds); gla_load(B, n0 + 1, h, s, w, fr, fq, Qg, KDT, CD, Vb);
        gla_step(C, S, c + 2, w, fr, fq, lds); gla_load(C, n0 + 2, h, s, w, fr, fq, Qg, KDT, CD, Vb);
        gla_step(D, S, c + 3, w, fr, fq, lds); gla_load(D, n0 + 3, h, s, w, fr, fq, Qg, KDT, CD, Vb);
        gla_step(A, S, c + 4, w, fr, fq, lds); gla_load(A, n1, h, s, w, fr, fq, Qg, KDT, CD, Vb);
        gla_step(B, S, c + 5, w, fr, fq, lds); gla_load(B, n1 + 1, h, s, w, fr, fq, Qg, KDT, CD, Vb);
        gla_step(C, S, c + 6, w, fr, fq, lds); gla_load(C, n1 + 2, h, s, w, fr, fq, Qg, KDT, CD, Vb);
        gla_step(D, S, c + 7, w, fr, fq, lds); gla_load(D, n1 + 3, h, s, w, fr, fq, Qg, KDT, CD, Vb);
        gla_flush(c + 7, u, tid, OGT, SSG, lds);
    }
    __syncthreads();
}

namespace at {
using bf16 = bf16_t;
using s16x4 = __attribute__((ext_vector_type(4))) short;
using f32x16 = __attribute__((ext_vector_type(16))) float;
constexpr int KVBLK = 64;
constexpr float SCALE = 0.07216878364870322f;
constexpr float THR = 8.f;
constexpr int SHM_V = 64 * 128 * 2, SHM_K = 64 * 192 * 2, SHM_ATTN = 2 * SHM_V + 2 * SHM_K + 8 * 64 * 4;
#define KSWZ(row, colB) ((row) * 384 + ((colB) ^ ((((row) >> 1) & 7) << 4)))
#define SBAR() __builtin_amdgcn_sched_barrier(0)
__device__ __forceinline__ int crow(int r, int hi) { return (r & 3) + 8 * (r >> 2) + 4 * hi; }
__device__ __forceinline__ unsigned cvtpk(float lo, float hi) { unsigned r; asm volatile("v_cvt_pk_bf16_f32 %0, %1, %2" : "=v"(r) : "v"(lo), "v"(hi)); return r; }
template <bool FIRST> __device__ __forceinline__ void partialSM(f32x16& p0, f32x16& p1, float& m_ref, float& alpha) {
  constexpr float THRL = THR * 1.4426950408889634f;
  float pmax = p0[0];
#pragma unroll
  for (int r = 1; r < 16; ++r) pmax = fmaxf(pmax, p0[r]);
#pragma unroll
  for (int r = 0; r < 16; ++r) pmax = fmaxf(pmax, p1[r]);
  { auto rr = __builtin_amdgcn_permlane32_swap(__float_as_uint(pmax), __float_as_uint(pmax), false, false);
    pmax = fmaxf(__uint_as_float(rr[0]), __uint_as_float(rr[1])); }
  if (!FIRST && __builtin_expect(__all(pmax <= THRL), 1)) { alpha = 1.f; }
  else { const float d = FIRST ? pmax : fmaxf(pmax, 0.f); m_ref += d; alpha = FIRST ? 0.f : __builtin_amdgcn_exp2f(-d);
#pragma unroll
    for (int r = 0; r < 16; ++r) { p0[r] -= d; p1[r] -= d; } }
#pragma unroll
  for (int r = 0; r < 16; ++r) p0[r] = __builtin_amdgcn_exp2f(p0[r]);
}
__device__ __forceinline__ void finishSM(f32x16& p0, f32x16& p1, float alpha, float& l_reg, bf16x8& pa0, bf16x8& pa1, bf16x8& pa2, bf16x8& pa3) {
#pragma unroll
  for (int r = 0; r < 16; ++r) p1[r] = __builtin_amdgcn_exp2f(p1[r]);
  float ps = 0;
#pragma unroll
  for (int r = 0; r < 16; ++r) ps += p0[r];
#pragma unroll
  for (int r = 0; r < 16; ++r) ps += p1[r];
  { auto rr = __builtin_amdgcn_permlane32_swap(__float_as_uint(ps), __float_as_uint(ps), false, false);
    ps = __uint_as_float(rr[0]) + __uint_as_float(rr[1]); }
  l_reg = l_reg * alpha + ps;
#define PK4(P, BASE, OUT) do { unsigned a0 = cvtpk(P[BASE + 0], P[BASE + 1]), a1 = cvtpk(P[BASE + 2], P[BASE + 3]);   \
    unsigned b0 = cvtpk(P[BASE + 4], P[BASE + 5]), b1 = cvtpk(P[BASE + 6], P[BASE + 7]);                              \
    auto r0 = __builtin_amdgcn_permlane32_swap(a0, b0, false, false); auto r1 = __builtin_amdgcn_permlane32_swap(a1, b1, false, false); \
    u32x4 w = {r0[0], r1[0], r0[1], r1[1]}; OUT = *reinterpret_cast<bf16x8*>(&w); } while (0)
  PK4(p0, 0, pa0); PK4(p0, 8, pa1); PK4(p1, 0, pa2); PK4(p1, 8, pa3);
#undef PK4
}
template <int BUF> __device__ __forceinline__ void qkt(f32x16& p0, f32x16& p1, const unsigned* kb, const bf16x8* qr, const char* Qs, bool visible, float m_ref) {
  typedef __attribute__((address_space(3))) const bf16x8* lds_frag;
  const float init = visible ? -m_ref : -1e30f;
#pragma unroll
  for (int r = 0; r < 16; ++r) { p0[r] = init; p1[r] = init; }
#pragma unroll
  for (int d0 = 0; d0 < 12; ++d0) {
    const bf16x8 qv = (d0 < 6) ? qr[d0 < 6 ? d0 : 0] : *reinterpret_cast<const bf16x8*>(Qs + (d0 - 6) * 1024);
    const bf16x8 b0 = *(lds_frag)(size_t)(kb[d0 & 3] + (unsigned)((d0 >> 2) * 128 + BUF));
    const bf16x8 b1 = *(lds_frag)(size_t)(kb[d0 & 3] + (unsigned)((d0 >> 2) * 128 + BUF + 32 * 384));
    p0 = __builtin_amdgcn_mfma_f32_32x32x16_bf16(b0, qv, p0, 0, 0, 0);
    p1 = __builtin_amdgcn_mfma_f32_32x32x16_bf16(b1, qv, p1, 0, 0, 0); }
}
__device__ __forceinline__ int v_st(int k, int c) { const int kk = (k & ~0xC) | ((k & 4) << 1) | ((k & 8) >> 1); return ((kk >> 3) * 4 + (c >> 5)) * 512 + ((kk & 7) * 32 + (c & 31)) * 2; }
__device__ __forceinline__ int v_rd_base(int lane) { return ((lane & 3) << 3) | (((lane >> 2) & 3) << 6) | (((lane >> 4) & 1) << 5) | (((lane >> 5) & 1) << 8); }
constexpr int v_rd_off(int d0, int ks, int half) { return d0 * 512 + ks * 4096 + half * 2048; }
template <int OFF> __device__ __forceinline__ s16x4 tr_read(int vb) {
  s16x4 r; asm volatile("ds_read_b64_tr_b16 %0, %1 offset:%2" : "=&v"(r) : "v"(vb), "i"(OFF) : "memory"); return r;
}
template <int D0> __device__ __forceinline__ void pv_one(f32x16& od, int vb, bf16x8 pa0, bf16x8 pa1, bf16x8 pa2, bf16x8 pa3) {
  const s16x4 l0 = tr_read<v_rd_off(D0, 0, 0)>(vb), h0 = tr_read<v_rd_off(D0, 0, 1)>(vb), l1 = tr_read<v_rd_off(D0, 1, 0)>(vb), h1 = tr_read<v_rd_off(D0, 1, 1)>(vb);
  const s16x4 l2 = tr_read<v_rd_off(D0, 2, 0)>(vb), h2 = tr_read<v_rd_off(D0, 2, 1)>(vb), l3 = tr_read<v_rd_off(D0, 3, 0)>(vb), h3 = tr_read<v_rd_off(D0, 3, 1)>(vb);
  asm volatile("s_waitcnt lgkmcnt(0)" ::: "memory"); SBAR();
#define PK(L, H) (bf16x8){L[0], L[1], L[2], L[3], H[0], H[1], H[2], H[3]}
  od = __builtin_amdgcn_mfma_f32_32x32x16_bf16(pa0, PK(l0, h0), od, 0, 0, 0);
  od = __builtin_amdgcn_mfma_f32_32x32x16_bf16(pa1, PK(l1, h1), od, 0, 0, 0);
  od = __builtin_amdgcn_mfma_f32_32x32x16_bf16(pa2, PK(l2, h2), od, 0, 0, 0);
  od = __builtin_amdgcn_mfma_f32_32x32x16_bf16(pa3, PK(l3, h3), od, 0, 0, 0);
#undef PK
}
__device__ __forceinline__ void pv_d0(f32x16* o, int vb, bf16x8 pa0, bf16x8 pa1, bf16x8 pa2, bf16x8 pa3) {
  pv_one<0>(o[0], vb, pa0, pa1, pa2, pa3); pv_one<1>(o[1], vb, pa0, pa1, pa2, pa3); pv_one<2>(o[2], vb, pa0, pa1, pa2, pa3); pv_one<3>(o[3], vb, pa0, pa1, pa2, pa3);
}
__device__ __forceinline__ void attn_unit(int b, int h, int qb, const bf16* QN, const bf16* QR, const float* COS, const float* SIN, const bf16* KN, const bf16* KPE, const bf16* VV, bf16* OM, char* lds) {
  int tid_ = threadIdx.x; asm volatile("" : "+v"(tid_));
  const int tid = tid_, wid = __builtin_amdgcn_readfirstlane(tid >> 6), lane = tid & 63, r32 = lane & 31, hi = lane >> 5;
  const long rowbase = (long)b * SEQ + (long)qb * 256;
  const bf16* Kh = KN + (long)b * SEQ * 1024 + h * 128; const bf16* Vh = VV + (long)b * SEQ * 1024 + h * 128; const bf16* Ph = KPE + (long)b * SEQ * 64;
  const int NT = 4 * qb + 4, vis = 4 * qb + (wid >> 1);
  bf16* V_lds = (bf16*)lds; bf16* K_lds = (bf16*)(lds + 2 * SHM_V);
  float* ws = (float*)(lds + 2 * SHM_V + 2 * SHM_K) + wid * 64; float* li_l = ws; float* al_l = ws + 32;
  float m_reg = 0.f, l_reg = 0; f32x16 o[4] = {}; bf16x8 qr[6];
  char* Qs = lds + SHM_ATTN + wid * 6144 + lane * 16;
  const bf16* Qw = QN + (rowbase + wid * 32 + r32) * 1024 + h * 128 + hi * 8; const bf16* Qw2 = QR + (rowbase + wid * 32 + r32) * 512 + h * 64 + hi * 8;
#pragma unroll
  for (int d0 = 0; d0 < 6; ++d0) qr[d0] = *reinterpret_cast<const bf16x8*>(Qw + d0 * 16);
#pragma unroll
  for (int d0 = 6; d0 < 8; ++d0) *reinterpret_cast<bf16x8*>(Qs + (d0 - 6) * 1024) = *reinterpret_cast<const bf16x8*>(Qw + d0 * 16);
#pragma unroll
  for (int g = 0; g < 2; ++g) {
    const u32x4 x1 = *reinterpret_cast<const u32x4*>(Qw2 + g * 16), x2 = *reinterpret_cast<const u32x4*>(Qw2 + 32 + g * 16);
    const float* cp = COS + (rowbase + wid * 32 + r32) * 32 + g * 16 + hi * 8; const float* sp = SIN + (rowbase + wid * 32 + r32) * 32 + g * 16 + hi * 8;
    const f32x4 c0 = *(const f32x4*)cp, c1 = *(const f32x4*)(cp + 4), s0 = *(const f32x4*)sp, s1 = *(const f32x4*)(sp + 4);
    const f32x4 a0 = {bf_lo(x1.x), bf_hi(x1.x), bf_lo(x1.y), bf_hi(x1.y)}, a1 = {bf_lo(x1.z), bf_hi(x1.z), bf_lo(x1.w), bf_hi(x1.w)};
    const f32x4 b0 = {bf_lo(x2.x), bf_hi(x2.x), bf_lo(x2.y), bf_hi(x2.y)}, b1 = {bf_lo(x2.z), bf_hi(x2.z), bf_lo(x2.w), bf_hi(x2.w)};
    *reinterpret_cast<u32x4*>(Qs + (2 + g) * 1024) = pack8(a0 * c0 - b0 * s0, a1 * c1 - b1 * s1);
    *reinterpret_cast<u32x4*>(Qs + (4 + g) * 1024) = pack8(b0 * c0 + a0 * s0, b1 * c1 + a1 * s1);
  }
  const int sr = tid >> 4, sc = (tid & 15) * 8, vst0 = v_st(sr, sc), vst1 = v_st(32 + sr, sc), pr = tid >> 3, pc = (tid & 7) * 8;
  const int vb0 = (int)(uintptr_t)V_lds + v_rd_base(lane);
  bf16x8 vs0, vs1, ks0, ks1, ks2;
#define SLOAD(k0) do { vs0 = *(const bf16x8*)(&Vh[(long)((k0) + sr) * 1024 + sc]); vs1 = *(const bf16x8*)(&Vh[(long)((k0) + 32 + sr) * 1024 + sc]); \
    ks0 = *(const bf16x8*)(&Kh[(long)((k0) + sr) * 1024 + sc]); ks1 = *(const bf16x8*)(&Kh[(long)((k0) + 32 + sr) * 1024 + sc]); \
    ks2 = *(const bf16x8*)(&Ph[(long)((k0) + pr) * 64 + pc]); } while (0)
#define SWRITE(bb) do { *(bf16x8*)((char*)V_lds + (bb) * SHM_V + vst0) = vs0; *(bf16x8*)((char*)V_lds + (bb) * SHM_V + vst1) = vs1; \
    *(bf16x8*)((char*)K_lds + (bb) * SHM_K + KSWZ(sr, sc * 2)) = ks0; *(bf16x8*)((char*)K_lds + (bb) * SHM_K + KSWZ(32 + sr, sc * 2)) = ks1; \
    *(bf16x8*)((char*)K_lds + (bb) * SHM_K + KSWZ(pr, (128 + pc) * 2)) = ks2; } while (0)
#define SWAIT() asm volatile("s_waitcnt vmcnt(0)" ::: "memory")
#define RESC(a) do { if (__any((a) < 1.f)) { if (hi == 0) al_l[r32] = (a); asm volatile("s_waitcnt lgkmcnt(0)" ::: "memory"); \
    _Pragma("unroll") for (int d = 0; d < 4; ++d) _Pragma("unroll") for (int r = 0; r < 16; ++r) o[d][r] *= al_l[crow(r, hi)]; } } while (0)
  f32x16 pA0, pA1, pB0, pB1; float alA, alB; bf16x8 pa0, pa1, pa2, pa3;
  unsigned kb[4];
#pragma unroll
  for (int k = 0; k < 4; ++k) kb[k] = (unsigned)(uintptr_t)K_lds + (unsigned)(r32 * 384 + ((32 * k + 16 * hi) ^ (((r32 >> 1) & 7) << 4)));
  SLOAD(0); SWAIT(); SWRITE(0); __syncthreads();
  qkt<0>(pA0, pA1, kb, qr, Qs, true, 0.f); partialSM<true>(pA0, pA1, m_reg, alA);
  SLOAD(KVBLK);
  SWAIT(); SWRITE(1); __syncthreads();
  for (int j = 1; j + 1 < NT; j += 2) {
    SBAR(); SLOAD((j + 1) * KVBLK); SBAR();
    qkt<SHM_K>(pB0, pB1, kb, qr, Qs, j <= vis, m_reg);
    finishSM(pA0, pA1, alA, l_reg, pa0, pa1, pa2, pa3); SBAR();
    pv_d0(o, vb0, pa0, pa1, pa2, pa3); partialSM<false>(pB0, pB1, m_reg, alB);
    __syncthreads(); SWAIT(); SWRITE(0);
    RESC(alB); __syncthreads();
    SBAR(); SLOAD((j + 2) * KVBLK); SBAR();
    qkt<0>(pA0, pA1, kb, qr, Qs, j + 1 <= vis, m_reg);
    finishSM(pB0, pB1, alB, l_reg, pa0, pa1, pa2, pa3); SBAR();
    pv_d0(o, vb0 + (int)SHM_V, pa0, pa1, pa2, pa3); partialSM<false>(pA0, pA1, m_reg, alA);
    __syncthreads(); SWAIT(); SWRITE(1);
    RESC(alA); __syncthreads();
  }
  SBAR(); qkt<SHM_K>(pB0, pB1, kb, qr, Qs, NT - 1 <= vis, m_reg);
  finishSM(pA0, pA1, alA, l_reg, pa0, pa1, pa2, pa3); SBAR();
  pv_d0(o, vb0, pa0, pa1, pa2, pa3); partialSM<false>(pB0, pB1, m_reg, alB);
  __syncthreads(); RESC(alB);
  finishSM(pB0, pB1, alB, l_reg, pa0, pa1, pa2, pa3); SBAR();
  pv_d0(o, vb0 + (int)SHM_V, pa0, pa1, pa2, pa3);
  if (hi == 0) li_l[r32] = l_reg; asm volatile("s_waitcnt lgkmcnt(0)" ::: "memory");
  float rli[16];
#pragma unroll
  for (int r = 0; r < 16; ++r) rli[r] = __builtin_amdgcn_rcpf(li_l[crow(r, hi)]);
  bf16* Ow = OM + (rowbase + wid * 32) * 1024 + h * 128;
#pragma unroll
  for (int r = 0; r < 16; ++r) { const int orow = crow(r, hi);
#pragma unroll
    for (int d0 = 0; d0 < 4; ++d0) Ow[(long)orow * 1024 + d0 * 32 + r32] = (bf16)(cvtpk(o[d0][r] * rli[r], 0.f) & 0xffffu); }
  __syncthreads();
#undef SLOAD
#undef SWRITE
#undef SWAIT
#undef RESC
}
#undef KSWZ
#undef SBAR
}

#define XB_TMO      128
#define XB_XCNT(j)  (256  + 64 * (j))
#define XB_XSUB(j)  (1280 + 64 * (j))
#define XB_XGEN(j)  (2304 + 64 * (j))
#define XB_TOP      3328
#define XB_TOPGEN   3392
#define XCD_BAR_WORDS 3456
#define XB_SPIN_CAP (1u << 18)

__device__ __forceinline__ unsigned xb_ld(unsigned* p)              { return __hip_atomic_load(p, __ATOMIC_RELAXED, __HIP_MEMORY_SCOPE_AGENT); }
__device__ __forceinline__ unsigned xb_add(unsigned* p, unsigned v) { return __hip_atomic_fetch_add(p, v, __ATOMIC_RELAXED, __HIP_MEMORY_SCOPE_AGENT); }
__device__ __forceinline__ unsigned xb_xcc_id() { return (unsigned)__builtin_amdgcn_s_getreg((3 << 11) | 20) & 0xFu; }
#define XB_SPIN(cond, bar) do { unsigned _sp = 0; while (cond) { __builtin_amdgcn_s_sleep(1); \
    if ((++_sp & 255u) == 0u) { if (xb_ld(&(bar)[XB_TMO])) break; if (_sp > XB_SPIN_CAP) { atomicAdd(&(bar)[XB_TMO], 1u); break; } } } } while (0)

struct XcdBarrier {
    unsigned* bar; unsigned x;
    volatile LAS unsigned* st;
};

__device__ __forceinline__ XcdBarrier xcd_barrier_post(unsigned* bar, volatile LAS unsigned* st) {
    XcdBarrier b; b.bar = bar; b.x = xb_xcc_id(); b.st = st;
    if (threadIdx.x == 0) (void)xb_add(&bar[XB_XCNT(b.x)], 1u);
    return b;
}
__device__ __forceinline__ void xcd_barrier_complete(unsigned* bar, unsigned x, unsigned& nloc, unsigned& nx) {
    const unsigned G = gridDim.x * gridDim.y * gridDim.z;
    unsigned sum, cnt, mine, sp = 0u;
    for (;;) {
        sum = 0u; cnt = 0u; mine = 0u;
#pragma unroll
        for (unsigned j = 0; j < 16; ++j) { const unsigned c = xb_ld(&bar[XB_XCNT(j)]); sum += c; cnt += (c > 0u) ? 1u : 0u; mine = (j == x) ? c : mine; }
        if (sum == G) break;
        __builtin_amdgcn_s_sleep(1);
        if ((++sp & 255u) == 0u) { if (xb_ld(&bar[XB_TMO])) break; if (sp > XB_SPIN_CAP) { atomicAdd(&bar[XB_TMO], 1u); break; } }
    }
    nloc = mine > 0u ? mine : 1u; nx = cnt > 0u ? cnt : 1u;
}

__device__ __forceinline__ void xcd_barrier(const XcdBarrier& b) {
    asm volatile("s_waitcnt vmcnt(0)" ::: "memory");
    __syncthreads();
    if (threadIdx.x == 0) {
        unsigned* bar = b.bar;
        __builtin_amdgcn_s_waitcnt(0);
        unsigned nloc = b.st[0], nx = b.st[1];
        if (nloc == 0u) { xcd_barrier_complete(bar, b.x, nloc, nx); b.st[0] = nloc; b.st[1] = nx; }
        const unsigned old = xb_add(&bar[XB_XSUB(b.x)], 1u);
        const unsigned gen = old / nloc;
        if (old + 1u == (gen + 1u) * nloc) {
            __builtin_amdgcn_fence(__ATOMIC_RELEASE, "agent");
            asm volatile("s_waitcnt vmcnt(0)" ::: "memory");
            const unsigned og = xb_add(&bar[XB_TOP], 1u);
            const unsigned tg = og / nx;
            if (og + 1u == (tg + 1u) * nx) xb_add(&bar[XB_TOPGEN], 1u);
            else XB_SPIN(xb_ld(&bar[XB_TOPGEN]) == tg, bar);
            __builtin_amdgcn_fence(__ATOMIC_ACQUIRE, "agent");
            xb_add(&bar[XB_XGEN(b.x)], 1u);
            asm volatile("s_waitcnt vmcnt(0)" ::: "memory");
        } else {
            XB_SPIN(xb_ld(&bar[XB_XGEN(b.x)]) == gen, bar);
            __builtin_amdgcn_fence(__ATOMIC_ACQUIRE, "agent");
            asm volatile("s_waitcnt vmcnt(0)" ::: "memory");
        }
    }
    __syncthreads();
}

constexpr int NPHASE = 13;
constexpr int IT_TAIL = 4096;
constexpr int LDS_BYTES = 147456;
struct Args { const void* in[22]; float* out; unsigned char* ws; int ph_lo, ph_hi, coop, pad; };

__global__ void __launch_bounds__(512, 2) fwd_kernel(Args a) {
    extern __shared__ __attribute__((aligned(16))) unsigned char lds_raw[];
    LAS unsigned char* lds = (LAS unsigned char*)lds_raw;
    const int wave = __builtin_amdgcn_readfirstlane(threadIdx.x >> 6);
#define PHASE_TID int tid = threadIdx.x; asm volatile("" : "+v"(tid)); const int lane = tid & 63; (void)lane;
    const int G = gridDim.x, bx = blockIdx.x, vcu = (G % 8 == 0) ? (bx % 8) * (G / 8) + bx / 8 : bx;
    const int gw = bx * 8 + wave, NGW = G * 8;
    unsigned char* ws = a.ws;
    Ins I;
    I.x = (const float*)a.in[0]; I.pos = (const int*)a.in[1]; I.pre_mix = (const float*)a.in[2]; I.w_in = (const float*)a.in[3]; I.w_a2 = (const float*)a.in[4]; I.b_a2 = (const float*)a.in[5];
    I.gla_norm = (const float*)a.in[6]; I.w_o_gla = (const float*)a.in[7]; I.q_norm = (const float*)a.in[8]; I.w_uq = (const float*)a.in[9]; I.kv_norm = (const float*)a.in[10];
    I.w_ukv = (const float*)a.in[11]; I.w_o_mla = (const float*)a.in[12]; I.w_gate = (const float*)a.in[13]; I.b_gate = (const float*)a.in[14]; I.w_out = (const float*)a.in[15];
    I.post_mix = (const float*)a.in[16]; I.pre_ffn = (const float*)a.in[17]; I.w_fg = (const float*)a.in[18]; I.w_fu = (const float*)a.in[19]; I.w_fd = (const float*)a.in[20]; I.post_ffn = (const float*)a.in[21];
    float* SS = (float*)(ws + WS_SS); float *SSQ = SS, *SSKV = SS + (size_t)8 * MROWS, *SSG = SS + (size_t)12 * MROWS, *SSY = SS + (size_t)76 * MROWS, *SSF = SS + (size_t)92 * MROWS;
    float* CD = (float*)(ws + WS_CD); float* COS = (float*)(ws + WS_COS); float* SIN = (float*)(ws + WS_SIN);
    bf16_t* WB = (bf16_t*)(ws + WS_WB); bf16_t* H = (bf16_t*)(ws + WS_H); bf16_t* Qg = (bf16_t*)(ws + WS_QG); bf16_t* Kg = (bf16_t*)(ws + WS_KG);
    bf16_t* Vb = (bf16_t*)(ws + WS_V); bf16_t* Gb = (bf16_t*)(ws + WS_G); bf16_t* MQ = (bf16_t*)(ws + WS_MQ); bf16_t* QR = (bf16_t*)(ws + WS_QR); bf16_t* OM = MQ; bf16_t* HID = MQ;
    bf16_t* KDT = (bf16_t*)(ws + WS_KDT); bf16_t* MISC = (bf16_t*)(ws + WS_MISC); bf16_t* CKV = (bf16_t*)(ws + WS_CKV); bf16_t* KPE = (bf16_t*)(ws + WS_KPE);
    bf16_t* KN = (bf16_t*)a.out; bf16_t* VV = KN + (size_t)MROWS * 1024; bf16_t* OGT = KN; bf16_t* YA = KN; bf16_t* YB = VV;
    bf16_t* MIX = Gb; bf16_t* Yo = Vb; bf16_t* Fo = Gb;
    const int lo = a.ph_lo, hi = a.ph_hi;
    volatile LAS unsigned* bst = (volatile LAS unsigned*)(lds + LDS_BYTES - 64);
    XcdBarrier xbar; xbar.bar = (unsigned*)ws; xbar.x = 0; xbar.st = bst;
    if (a.coop) { if (threadIdx.x < 2) bst[threadIdx.x] = 0u; __syncthreads(); xbar = xcd_barrier_post((unsigned*)ws, bst); }
#ifndef PH_MASK
#define PH_MASK 0x1FFF
#endif
#define IN(k) (((PH_MASK >> (k)) & 1) && lo <= (k) && (k) < hi)
#define SEAM(k) do { if (a.coop && IN(k) && IN((k) + 1)) { if (a.pad == 0x5eed) cg::this_grid().sync(); xcd_barrier(xbar); } } while (0)

    if (IN(0)) { PHASE_TID
        LAS float* scr = (LAS float*)(lds + wave * 16384);
        const int p1_units = (MROWS / 256) * (N1 / 256), p1_full = p1_units % G;
        const int it_p0 = (p1_full != 0) ? IT_TOTAL - IT_TAIL : IT_TOTAL;
        for (int it = gw; it < it_p0; it += NGW) weight_item(it, I, WB, scr, lane);
        for (int m = gw; m < MROWS; m += 2 * NGW) {
            const int m2 = m + NGW;
            const f32x4* xa = (const f32x4*)(I.x + (size_t)m * DM) + lane; const f32x4* xb = (const f32x4*)(I.x + (size_t)(m2 < MROWS ? m2 : m) * DM) + lane; const f32x4* gr = (const f32x4*)I.pre_mix + lane;
            f32x4 va[4], vb[4]; float sa = 0.f, sb = 0.f;
#pragma unroll
            for (int j = 0; j < 4; ++j) { va[j] = xa[64 * j]; vb[j] = xb[64 * j]; }
#pragma unroll
            for (int j = 0; j < 4; ++j) { sa += dot4(va[j]); sb += dot4(vb[j]); }
            const float ra = rsqrtf(wave_sum(sa) * (1.f / 1024.f) + EPS), rb = rsqrtf(wave_sum(sb) * (1.f / 1024.f) + EPS);
            u32x2* oa = (u32x2*)(H + (size_t)m * DM) + lane; u32x2* ob = (u32x2*)(H + (size_t)(m2 < MROWS ? m2 : m) * DM) + lane;
#pragma unroll
            for (int j = 0; j < 4; ++j) { const f32x4 g = gr[64 * j]; u32x2 w;
                w.x = pk2(va[j][0] * ra * g[0], va[j][1] * ra * g[1]); w.y = pk2(va[j][2] * ra * g[2], va[j][3] * ra * g[3]); oa[64 * j] = w;
                if (m2 < MROWS) { w.x = pk2(vb[j][0] * rb * g[0], vb[j][1] * rb * g[1]); w.y = pk2(vb[j][2] * rb * g[2], vb[j][3] * rb * g[3]); ob[64 * j] = w; } }
        }
        for (int i = bx * 512 + tid; i < MROWS * 32; i += G * 512) {
            const int row = i >> 5, f = i & 31;
            const float inv = __builtin_amdgcn_exp2f(-(float)f * (13.287712379549449f / 32.f));
            float rev = (float)I.pos[row] * inv * 0.15915494309189535f; rev -= rintf(rev);
            COS[i] = __builtin_amdgcn_cosf(rev); SIN[i] = __builtin_amdgcn_sinf(rev);
        }
    }
    SEAM(0);
    if (IN(1)) { PHASE_TID
        { EpiG1 E{Qg, Kg, Vb, Gb, CKV, MISC, SSQ, SSKV}; run_gemm(lds, H, 1024, WB + WO_W1, N1, 1024, E); }
        const int p1_units = (MROWS / 256) * (N1 / 256), p1_full = p1_units % G;
        if (p1_full != 0 && bx >= p1_full) {
            LAS float* scr = (LAS float*)(lds + wave * 16384); const int nsw = (G - p1_full) * 8, lw = (bx - p1_full) * 8 + wave;
            for (int it = IT_TOTAL - IT_TAIL + lw; it < IT_TOTAL; it += nsw) weight_item(it, I, WB, scr, lane);
        }
    }
    SEAM(1);
    if (IN(2)) { PHASE_TID
        for (int i = bx * 512 + tid; i < MROWS * 32; i += G * 512) {
            const int row = i >> 5, f = i & 31; const float c = COS[i], s = SIN[i];
            const float x1 = bf1(MISC[(size_t)row * 512 + 384 + f]), x2 = bf1(MISC[(size_t)row * 512 + 416 + f]);
            KPE[(size_t)row * 64 + f] = (bf16_t)(pk2(x1 * c - x2 * s, 0.f) & 0xffffu); KPE[(size_t)row * 64 + 32 + f] = (bf16_t)(pk2(x2 * c + x1 * s, 0.f) & 0xffffu);
        }
#ifndef SKIP_PREP
        for (int it = bx; it < NCHUNK * 4; it += G) gla_prep_item(it, Kg, MISC, I.w_a2, I.b_a2, KDT, CD, (LAS float*)lds);
#endif
        { EpiQ E{MQ, QR, SSQ}; run_gemm(lds, MISC, 512, WB + WO_UQ, NUQ, 512, E); }
#ifndef SKIP_KV
        { EpiKV E{KN, VV, SSKV}; run_gemm(lds, CKV, 256, WB + WO_UKV, NUKV, 256, E); }
#endif
    }
    SEAM(2);
    if (IN(3)) {
        for (int idx = vcu; idx < 1024; idx += G) {
            const int v = idx & 255, i = idx >> 8, s = v & 7, bh = v >> 3; const int qb = (i == 0) ? s : (i == 1) ? 15 - s : (i == 2) ? 16 + s : 31 - s;
            at::attn_unit(bh >> 3, bh & 7, qb, MQ, QR, COS, SIN, KN, KPE, VV, OM, (char*)lds_raw);
        }
    }
    SEAM(3);
    if (IN(4)) { for (int u = vcu; u < 256; u += G) gla_unit(u, Qg, KDT, CD, Vb, OGT, SSG, lds); }
    SEAM(4);
    if (IN(5)) { PHASE_TID
        for (int m = gw; m < MROWS; m += NGW) {
            bf16_t* orow = Vb + (size_t)m * 1024 + 16 * lane; const bf16_t* grow = Gb + (size_t)m * 1024 + 16 * lane;
            const bf16_t* irow = OGT + ((size_t)(((m >> 13) * 4 + (lane >> 4)) * 16 + (lane & 15)) * SEQ + (m & (SEQ - 1))) * 16;
            const u32x4 ovA = *(const u32x4*)(irow), ovB = *(const u32x4*)(irow + 8);
            float ssg = ((bf_lo(ovA.x) * bf_lo(ovA.x) + bf_hi(ovA.x) * bf_hi(ovA.x)) + (bf_lo(ovA.y) * bf_lo(ovA.y) + bf_hi(ovA.y) * bf_hi(ovA.y))) + ((bf_lo(ovA.z) * bf_lo(ovA.z) + bf_hi(ovA.z) * bf_hi(ovA.z)) + (bf_lo(ovA.w) * bf_lo(ovA.w) + bf_hi(ovA.w) * bf_hi(ovA.w)));
            ssg += ((bf_lo(ovB.x) * bf_lo(ovB.x) + bf_hi(ovB.x) * bf_hi(ovB.x)) + (bf_lo(ovB.y) * bf_lo(ovB.y) + bf_hi(ovB.y) * bf_hi(ovB.y))) + ((bf_lo(ovB.z) * bf_lo(ovB.z) + bf_hi(ovB.z) * bf_hi(ovB.z)) + (bf_lo(ovB.w) * bf_lo(ovB.w) + bf_hi(ovB.w) * bf_hi(ovB.w)));
            ssg += __shfl_xor(ssg, 1); ssg += __shfl_xor(ssg, 2); ssg += __shfl_xor(ssg, 4); ssg += __shfl_xor(ssg, 8);
            const float rs = rsqrtf(ssg * (1.f / 256.f) + EPS); const float* gn = I.gla_norm + 16 * (lane & 15);
#pragma unroll
            for (int k = 0; k < 2; ++k) {
                const u32x4 ov = *(const u32x4*)(irow + 8 * k), gv = *(const u32x4*)(grow + 8 * k); const f32x4 n0 = *(const f32x4*)(gn + 8 * k), n1 = *(const f32x4*)(gn + 8 * k + 4);
                f32x4 r0, r1; float g;
                g = bf_lo(gv.x); r0[0] = bf_lo(ov.x) * rs * n0[0] * g * sigm(g); g = bf_hi(gv.x); r0[1] = bf_hi(ov.x) * rs * n0[1] * g * sigm(g);
                g = bf_lo(gv.y); r0[2] = bf_lo(ov.y) * rs * n0[2] * g * sigm(g); g = bf_hi(gv.y); r0[3] = bf_hi(ov.y) * rs * n0[3] * g * sigm(g);
                g = bf_lo(gv.z); r1[0] = bf_lo(ov.z) * rs * n1[0] * g * sigm(g); g = bf_hi(gv.z); r1[1] = bf_hi(ov.z) * rs * n1[1] * g * sigm(g);
                g = bf_lo(gv.w); r1[2] = bf_lo(ov.w) * rs * n1[2] * g * sigm(g); g = bf_hi(gv.w); r1[3] = bf_hi(ov.w) * rs * n1[3] * g * sigm(g);
                *(u32x4*)(orow + 8 * k) = pack8(r0, r1);
            }
        }
        { EpiStore<false> E{YB, 1024, nullptr}; run_gemm(lds, OM, 1024, WB + WO_OMLA, 1024, 1024, E); }
    }
    SEAM(5);
    if (IN(6)) { EpiStore<false> E{YA, 1024, nullptr}; run_gemm(lds, Vb, 1024, WB + WO_OGLA, 1024, 1024, E); }
    SEAM(6);
    if (IN(7)) { EpiMerge E{YA, YB, I.b_gate, MIX}; run_gemm(lds, H, 1024, WB + WO_GATE, NGATE, 1024, E); }
    SEAM(7);
    if (IN(8)) { EpiStore<true> E{Yo, 1024, SSY}; run_gemm(lds, MIX, 1024, WB + WO_OUT, 1024, 1024, E); }
    SEAM(8);
    if (IN(9)) { PHASE_TID
        for (int m = gw; m < MROWS; m += NGW) {
            const f32x4* xr = (const f32x4*)(I.x + (size_t)m * DM) + lane; const u32x2* yr = (const u32x2*)(Yo + (size_t)m * DM) + lane;
            const f32x4* g1 = (const f32x4*)I.post_mix + lane; const f32x4* g2 = (const f32x4*)I.pre_ffn + lane;
            float ssm; { const f32x4* sp = (const f32x4*)(SSY + (size_t)m * 16); const f32x4 t0 = sp[0], t1 = sp[1], t2 = sp[2], t3 = sp[3];
                ssm = (((t0[0] + t0[1]) + (t0[2] + t0[3])) + ((t1[0] + t1[1]) + (t1[2] + t1[3]))) + (((t2[0] + t2[1]) + (t2[2] + t2[3])) + ((t3[0] + t3[1]) + (t3[2] + t3[3]))); }
            const float rs = rsqrtf(ssm * (1.f / 1024.f) + EPS);
            f32x4 v[4]; float s = 0.f;
#pragma unroll
            for (int j = 0; j < 4; ++j) { const f32x4 xv = xr[64 * j]; const u32x2 yv = yr[64 * j]; const f32x4 gv = g1[64 * j];
                v[j][0] = xv[0] + bf_lo(yv.x) * rs * gv[0]; v[j][1] = xv[1] + bf_hi(yv.x) * rs * gv[1]; v[j][2] = xv[2] + bf_lo(yv.y) * rs * gv[2]; v[j][3] = xv[3] + bf_hi(yv.y) * rs * gv[3];
                s += dot4(v[j]); }
            const float rs2 = rsqrtf(wave_sum(s) * (1.f / 1024.f) + EPS);
            u32x2* hrow = (u32x2*)(H + (size_t)m * DM) + lane;
#pragma unroll
            for (int j = 0; j < 4; ++j) { const f32x4 gv = g2[64 * j]; u32x2 w; w.x = pk2(v[j][0] * rs2 * gv[0], v[j][1] * rs2 * gv[1]); w.y = pk2(v[j][2] * rs2 * gv[2], v[j][3] * rs2 * gv[3]); hrow[64 * j] = w; }
        }
    }
    SEAM(9);
    if (IN(10)) { EpiSwiglu E{HID}; run_gemm(lds, H, 1024, WB + WO_GU, NGU, 1024, E); }
    SEAM(10);
    if (IN(11)) { EpiStore<true> E{Fo, 1024, SSF}; run_gemm(lds, HID, DFF, WB + WO_DOWN, 1024, DFF, E); }
    SEAM(11);
    if (IN(12)) { PHASE_TID
        for (int m = gw; m < MROWS; m += NGW) {
            f32x4* orow = (f32x4*)(a.out + (size_t)m * DM) + lane; const f32x4* xr = (const f32x4*)(I.x + (size_t)m * DM) + lane;
            const u32x2* yr = (const u32x2*)(Yo + (size_t)m * DM) + lane; const u32x2* fr_ = (const u32x2*)(Fo + (size_t)m * DM) + lane;
            const f32x4* g1 = (const f32x4*)I.post_mix + lane; const f32x4* g2 = (const f32x4*)I.post_ffn + lane;
            float ss1, ss2;
            { const f32x4* sp = (const f32x4*)(SSY + (size_t)m * 16); const f32x4 t0 = sp[0], t1 = sp[1], t2 = sp[2], t3 = sp[3];
              ss1 = (((t0[0] + t0[1]) + (t0[2] + t0[3])) + ((t1[0] + t1[1]) + (t1[2] + t1[3]))) + (((t2[0] + t2[1]) + (t2[2] + t2[3])) + ((t3[0] + t3[1]) + (t3[2] + t3[3]))); }
            { const f32x4* sp = (const f32x4*)(SSF + (size_t)m * 16); const f32x4 t0 = sp[0], t1 = sp[1], t2 = sp[2], t3 = sp[3];
              ss2 = (((t0[0] + t0[1]) + (t0[2] + t0[3])) + ((t1[0] + t1[1]) + (t1[2] + t1[3]))) + (((t2[0] + t2[1]) + (t2[2] + t2[3])) + ((t3[0] + t3[1]) + (t3[2] + t3[3]))); }
            const float rs1 = rsqrtf(ss1 * (1.f / 1024.f) + EPS), rs2 = rsqrtf(ss2 * (1.f / 1024.f) + EPS);
#pragma unroll
            for (int j = 0; j < 4; ++j) { const f32x4 xv = xr[64 * j]; const u32x2 yv = yr[64 * j], fv = fr_[64 * j]; const f32x4 ga = g1[64 * j], gb = g2[64 * j]; f32x4 o;
                o[0] = (xv[0] + bf_lo(yv.x) * rs1 * ga[0]) + bf_lo(fv.x) * rs2 * gb[0]; o[1] = (xv[1] + bf_hi(yv.x) * rs1 * ga[1]) + bf_hi(fv.x) * rs2 * gb[1];
                o[2] = (xv[2] + bf_lo(yv.y) * rs1 * ga[2]) + bf_lo(fv.y) * rs2 * gb[2]; o[3] = (xv[3] + bf_hi(yv.y) * rs1 * ga[3]) + bf_hi(fv.y) * rs2 * gb[3];
                orow[64 * j] = o; }
        }
    }
#undef IN
#undef SEAM
}


#ifdef DBG_STOP
__global__ void dbg_copy(unsigned char* ws, float* out) {
    const bf16_t* Vb = (const bf16_t*)(ws + WS_V); const bf16_t* Gb = (const bf16_t*)(ws + WS_G); const bf16_t* Qg = (const bf16_t*)(ws + WS_QG); const bf16_t* Kg = (const bf16_t*)(ws + WS_KG);
    const bf16_t* MISC = (const bf16_t*)(ws + WS_MISC); const bf16_t* CKV = (const bf16_t*)(ws + WS_CKV); const bf16_t* QN = (const bf16_t*)(ws + WS_MQ); const bf16_t* QR = (const bf16_t*)(ws + WS_QR);
    const bf16_t* KDT = (const bf16_t*)(ws + WS_KDT); const bf16_t* KPE = (const bf16_t*)(ws + WS_KPE); const bf16_t* KN = (const bf16_t*)out; const bf16_t* H = (const bf16_t*)(ws + WS_H);
    const float* CD = (const float*)(ws + WS_CD);
    for (size_t i = (size_t)blockIdx.x * blockDim.x + threadIdx.x; i < (size_t)MROWS * 1024; i += (size_t)gridDim.x * blockDim.x) {
        const size_t row = i >> 10, c = i & 1023; float v = 0.f;
#if DBG_STOP == 1
        v = bf1(Vb[i]) + bf1(Gb[i]) + bf1(Qg[row * 512 + (c & 511)]) + bf1(Kg[row * 512 + (c & 511)]) + bf1(MISC[row * 512 + (c & 511)]) + bf1(CKV[row * 256 + (c & 255)]) + bf1(H[i]);
#elif DBG_STOP == 2
        v = bf1(QN[i]) + bf1(QR[row * 512 + (c & 511)]) + bf1(KPE[row * 64 + (c & 63)]) + bf1(KDT[row * 512 + (c & 511)]) + CD[(row * 8 + (c & 7)) & 262143];
#elif DBG_STOP == 3
        v = bf1(QN[i]);
#elif DBG_STOP == 4
        v = ((const float*)(ws + WS_SS))[(size_t)12 * MROWS + row * 64 + (c & 63)];
#endif
        out[i] = v;
    }
}
#endif
#ifndef MK_N_LAUNCHES
#define MK_N_LAUNCHES 1
#endif
extern "C" void kernel_launch(void* const* d_in, const int* in_sizes, int n_in, void* d_out, int out_size, void* d_ws, size_t ws_size, hipStream_t stream) {
    static int grid = 0;
    if (grid == 0) {
        if (n_in != 22 || out_size != MROWS * DM || ws_size < WS_END) { fprintf(stderr, "kernel_launch: unexpected shapes (n_in %d out %d ws %zu)\n", n_in, out_size, ws_size); grid = -1; return; }
        int dev = 0, cus = 0, per_cu = 0;
        hipGetDevice(&dev); hipDeviceGetAttribute(&cus, hipDeviceAttributeMultiprocessorCount, dev);
        if (hipFuncSetAttribute((const void*)fwd_kernel, hipFuncAttributeMaxDynamicSharedMemorySize, LDS_BYTES) != hipSuccess) { fprintf(stderr, "kernel_launch: hipFuncSetAttribute failed\n"); grid = -1; return; }
        hipOccupancyMaxActiveBlocksPerMultiprocessor(&per_cu, (const void*)fwd_kernel, 512, LDS_BYTES);
        (void)hipGetLastError();
        if (per_cu < 1) per_cu = 1;
        grid = cus;
    }
    if (grid < 0) return;
    if (hipMemsetAsync(d_ws, 0, 16384, stream) != hipSuccess) { fprintf(stderr, "kernel_launch: memset failed\n"); return; }
    Args a{};
    for (int i = 0; i < 22; ++i) a.in[i] = d_in[i];
    a.out = (float*)d_out; a.ws = (unsigned char*)d_ws;
#if MK_N_LAUNCHES == 1
    a.ph_lo = 0; a.ph_hi = NPHASE; a.coop = 1;
    void* args[] = {&a};
    hipError_t e = hipLaunchCooperativeKernel((const void*)fwd_kernel, dim3(grid), dim3(512), args, LDS_BYTES, stream);
    if (e != hipSuccess) fprintf(stderr, "cooperative launch failed: %s (grid %d)\n", hipGetErrorString(e), grid);
#else
#ifdef DBG_STOP
    const int np = DBG_STOP + 1;
    for (int p = 0; p < np; ++p) { a.ph_lo = p; a.ph_hi = p + 1; a.coop = 0; hipLaunchKernelGGL(fwd_kernel, dim3(grid), dim3(512), LDS_BYTES, stream, a); }
    hipLaunchKernelGGL(dbg_copy, dim3(2048), dim3(256), 0, stream, (unsigned char*)d_ws, (float*)d_out);
#else
    for (int p = 0; p < NPHASE; ++p) { a.ph_lo = p; a.ph_hi = p + 1; a.coop = 0; hipLaunchKernelGGL(fwd_kernel, dim3(grid), dim3(512), LDS_BYTES, stream, a); }
#endif
#endif
}
```
